# Optimizing an MI355X kernel written in HIP

```python
import math
import jax, jax.numpy as jnp
from jax import lax
import numpy as np

D_MODEL = 1024
BATCH = 2
SEQ = 8192
DEPTH = 1

HEAD_DIM = 64
NSA_HEADS = 8
NSA_GROUPS = 2
NSA_HPG = NSA_HEADS // NSA_GROUPS
CMP_LEN = 32
CMP_STRIDE = 16
CMP_HIDDEN = 256
SEL_BLOCK = 64
SEL_TOPN = 16
WINDOW = 512
SB_HEADS = 8
Q_BLOCK = 128
ROPE_THETA = 10000.0
PEER_HEADS = 8
PEER_NKEYS = 128
PEER_N_EXPERTS = PEER_NKEYS * PEER_NKEYS
PEER_QDIM = 256
PEER_TOPK = 16
PEER_CHUNK = 128
EPS = 1e-6
NEG = -1e30

NSA_W = NSA_HEADS * HEAD_DIM
KV_W = NSA_GROUPS * HEAD_DIM
SB_W = SB_HEADS * HEAD_DIM
IN_WIDTH = NSA_W + 6 * KV_W + 3 * NSA_HEADS + 3 * SB_W + 2 * D_MODEL

kernel_name = "hybrid_nsa_stickbreaking_peer_block"


def rms_norm(x, g):
    xf = x.astype(jnp.float32)
    return xf * lax.rsqrt(jnp.mean(xf * xf, axis=-1, keepdims=True) + EPS) * g.astype(jnp.float32)


def rope(x, pos):
    half = HEAD_DIM // 2
    freqs = ROPE_THETA ** (-jnp.arange(half, dtype=jnp.float32) / half)
    ang = pos.astype(jnp.float32)[:, None] * freqs[None, :]
    cos, sin = jnp.cos(ang), jnp.sin(ang)
    x1, x2 = x[..., :half], x[..., half:]
    return jnp.concatenate([x1 * cos - x2 * sin, x2 * cos + x1 * sin], axis=-1)


def compress(tok, pos_emb, w1, w2):
    s = tok.shape[2]
    nc = (s - CMP_LEN) // CMP_STRIDE + 1
    idx = jnp.arange(nc)[:, None] * CMP_STRIDE + jnp.arange(CMP_LEN)[None, :]
    blocks = tok[:, :, idx] + pos_emb.astype(jnp.float32)
    flat = blocks.reshape(blocks.shape[0], blocks.shape[1], nc, CMP_LEN * HEAD_DIM)
    return jax.nn.gelu(flat @ w1) @ w2


def token_mixers(xn, w_in, q_norm_g, k_norm_g, cmp_pos_k, cmp_pos_v, cmp_k_w1, cmp_k_w2,
                 cmp_v_w1, cmp_v_w2, w_branch_nsa, w_branch_sb, w_out):
    b, s, _ = xn.shape
    scale = 1.0 / math.sqrt(HEAD_DIM)
    pos = jnp.arange(s)
    proj = xn @ w_in
    c0 = NSA_W
    c1 = c0 + 6 * KV_W
    c2 = c1 + 3 * NSA_HEADS
    c3 = c2 + 3 * SB_W
    q_n, kv_n, g_n, qkv_sb, br_g = jnp.split(proj, [c0, c1, c2, c3], axis=-1)

    q = q_n.reshape(b, s, NSA_GROUPS, NSA_HPG, HEAD_DIM).transpose(0, 2, 3, 1, 4)
    q = rope(rms_norm(q, q_norm_g), pos)
    kv = kv_n.reshape(b, s, 6, NSA_GROUPS, HEAD_DIM).transpose(2, 0, 3, 1, 4)
    k_c, v_c, k_s, v_s, k_w, v_w = kv[0], kv[1], kv[2], kv[3], kv[4], kv[5]
    nc = (s - CMP_LEN) // CMP_STRIDE + 1
    cmp_end = jnp.arange(nc) * CMP_STRIDE + CMP_LEN - 1
    kc = rope(rms_norm(compress(k_c, cmp_pos_k, cmp_k_w1, cmp_k_w2), k_norm_g[0]), cmp_end)
    vc = compress(v_c, cmp_pos_v, cmp_v_w1, cmp_v_w2)
    k_s = rope(rms_norm(k_s, k_norm_g[1]), pos)
    k_w = rope(rms_norm(k_w, k_norm_g[2]), pos)
    ns = s // SEL_BLOCK
    n_sel = min(SEL_TOPN, ns)
    ks_blocks = k_s.reshape(b, NSA_GROUPS, ns, SEL_BLOCK, HEAD_DIM)
    vs_blocks = v_s.reshape(b, NSA_GROUPS, ns, SEL_BLOCK, HEAD_DIM)
    pad = ((0, 0), (0, 0), (WINDOW, 0), (0, 0))
    kw_pad = jnp.pad(k_w, pad)
    vw_pad = jnp.pad(v_w, pad)
    g_nsa = jax.nn.sigmoid(g_n.reshape(b, s, 3, NSA_GROUPS, NSA_HPG).transpose(2, 0, 3, 4, 1))
    c_start = jnp.arange(nc) * CMP_STRIDE
    j_start = jnp.arange(ns) * SEL_BLOCK
    overlap = jnp.clip(jnp.minimum(c_start[:, None] + CMP_LEN, j_start[None, :] + SEL_BLOCK)
                       - jnp.maximum(c_start[:, None], j_start[None, :]), 0).astype(jnp.float32) / CMP_LEN
    bi = jnp.arange(b)[:, None, None, None]
    gi = jnp.arange(NSA_GROUPS)[None, :, None, None]
    blk = jnp.arange(ns)

    sb = qkv_sb.reshape(b, s, 3, SB_HEADS, HEAD_DIM).transpose(2, 0, 3, 1, 4)
    q_sb, k_sb, v_sb = sb[0], sb[1], sb[2]

    def block_fn(bidx):
        t0 = bidx * Q_BLOCK
        t = t0 + jnp.arange(Q_BLOCK)
        qb = lax.dynamic_slice_in_dim(q, t0, Q_BLOCK, axis=3)
        sc = jnp.einsum('bghtd,bgcd->bghtc', qb, kc) * scale
        cmask = cmp_end[None, :] <= t[:, None]
        has_c = (t >= CMP_LEN - 1).astype(jnp.float32)[:, None]
        pc = jax.nn.softmax(jnp.where(cmask, sc, NEG), axis=-1) * has_c
        o_cmp = jnp.einsum('bghtc,bgcd->bghtd', pc, vc)
        imp = jnp.einsum('bghtc,cj->bgtj', pc, overlap)
        cur = t // SEL_BLOCK
        forced = (blk[None, :] == 0) | (blk[None, :] == cur[:, None]) | (blk[None, :] == cur[:, None] - 1)
        valid = blk[None, :] * SEL_BLOCK <= t[:, None]
        score = jnp.where(forced, 1e4, jnp.where(valid, imp, -1e4))
        _, sel = lax.top_k(score, n_sel)
        ks_g = ks_blocks[bi, gi, sel]
        vs_g = vs_blocks[bi, gi, sel]
        ss = jnp.einsum('bghtd,bgtnld->bghtnl', qb, ks_g) * scale
        spos = sel[..., None] * SEL_BLOCK + jnp.arange(SEL_BLOCK)
        smask = spos <= t[None, None, :, None, None]
        ps = jax.nn.softmax(jnp.where(smask[:, :, None], ss, NEG), axis=(-2, -1))
        o_sel = jnp.einsum('bghtnl,bgtnld->bghtd', ps, vs_g)
        kwb = lax.dynamic_slice_in_dim(kw_pad, t0, WINDOW + Q_BLOCK, axis=2)
        vwb = lax.dynamic_slice_in_dim(vw_pad, t0, WINDOW + Q_BLOCK, axis=2)
        wpos = t0 - WINDOW + jnp.arange(WINDOW + Q_BLOCK)
        wmask = (wpos[None, :] >= 0) & (wpos[None, :] <= t[:, None]) & (wpos[None, :] > t[:, None] - WINDOW)
        sw = jnp.einsum('bghtd,bgkd->bghtk', qb, kwb) * scale
        pw = jax.nn.softmax(jnp.where(wmask, sw, NEG), axis=-1)
        o_win = jnp.einsum('bghtk,bgkd->bghtd', pw, vwb)
        gb = lax.dynamic_slice_in_dim(g_nsa, t0, Q_BLOCK, axis=4)[..., None]
        o_nsa = gb[0] * o_cmp + gb[1] * o_sel + gb[2] * o_win
        qsb = lax.dynamic_slice_in_dim(q_sb, t0, Q_BLOCK, axis=2)
        z = jnp.einsum('bhtd,bhsd->bhts', qsb, k_sb) * scale
        m = pos[None, :] < t[:, None]
        l1m = jnp.where(m, jax.nn.log_sigmoid(-z), 0.0)
        after = lax.cumsum(l1m, axis=3, reverse=True) - l1m
        a_w = jnp.where(m, jnp.exp(jax.nn.log_sigmoid(z) + after), 0.0)
        o_sb = jnp.einsum('bhts,bhsd->bhtd', a_w, v_sb)
        return o_nsa, o_sb

    o_nsa_all, o_sb_all = lax.map(block_fn, jnp.arange(s // Q_BLOCK))
    o_nsa = o_nsa_all.transpose(1, 0, 4, 2, 3, 5).reshape(b, s, NSA_W)
    o_sb = o_sb_all.transpose(1, 0, 3, 2, 4).reshape(b, s, SB_W)
    gate_a, gate_b = jnp.split(jax.nn.sigmoid(br_g), 2, axis=-1)
    merged = gate_a * (o_nsa @ w_branch_nsa) + gate_b * (o_sb @ w_branch_sb)
    return merged @ w_out


def peer(xn, wq, subkeys, u, v):
    d = xn.shape[-1]
    tokens = xn.reshape(-1, PEER_CHUNK, d)

    def chunk_fn(xc):
        q = (xc @ wq).reshape(PEER_CHUNK, PEER_HEADS, 2, PEER_QDIM // 2)
        sc = jnp.einsum('thpd,pkd->thpk', q, subkeys)
        sv, si = lax.top_k(sc, PEER_TOPK)
        cand = sv[:, :, 0, :, None] + sv[:, :, 1, None, :]
        cv, ci = lax.top_k(cand.reshape(PEER_CHUNK, PEER_HEADS, PEER_TOPK * PEER_TOPK), PEER_TOPK)
        i1 = jnp.take_along_axis(si[:, :, 0], ci // PEER_TOPK, axis=-1)
        i2 = jnp.take_along_axis(si[:, :, 1], ci % PEER_TOPK, axis=-1)
        e = i1 * PEER_NKEYS + i2
        g = jax.nn.softmax(cv.astype(jnp.float32), axis=-1)
        act = jax.nn.gelu(jnp.einsum('td,thkd->thk', xc, u[e]))
        return jnp.einsum('thk,thkd->td', g * act, v[e])

    return lax.map(chunk_fn, tokens).reshape(xn.shape)


def setup_inputs(seed: int = 0) -> dict:
    key = jax.random.key(seed)
    ks = jax.random.split(key, 20)
    f = jnp.float32
    nrm = lambda k, shape, sc: jax.random.normal(k, shape, f) * sc
    L = DEPTH
    return {
        "x": nrm(ks[0], (BATCH, SEQ, D_MODEL), 1.0),
        "norm1_g": 1.0 + nrm(ks[1], (L, D_MODEL), 0.02),
        "w_in": nrm(ks[2], (L, D_MODEL, IN_WIDTH), D_MODEL ** -0.5),
        "q_norm_g": 1.0 + nrm(ks[3], (L, HEAD_DIM), 0.02),
        "k_norm_g": 1.0 + nrm(ks[4], (L, 3, HEAD_DIM), 0.02),
        "cmp_pos_k": nrm(ks[5], (L, CMP_LEN, HEAD_DIM), 0.1),
        "cmp_pos_v": nrm(ks[6], (L, CMP_LEN, HEAD_DIM), 0.1),
        "cmp_k_w1": nrm(ks[7], (L, CMP_LEN * HEAD_DIM, CMP_HIDDEN), (CMP_LEN * HEAD_DIM) ** -0.5),
        "cmp_k_w2": nrm(ks[8], (L, CMP_HIDDEN, HEAD_DIM), CMP_HIDDEN ** -0.5),
        "cmp_v_w1": nrm(ks[9], (L, CMP_LEN * HEAD_DIM, CMP_HIDDEN), (CMP_LEN * HEAD_DIM) ** -0.5),
        "cmp_v_w2": nrm(ks[10], (L, CMP_HIDDEN, HEAD_DIM), CMP_HIDDEN ** -0.5),
        "w_branch_nsa": nrm(ks[11], (L, NSA_W, D_MODEL), NSA_W ** -0.5),
        "w_branch_sb": nrm(ks[12], (L, SB_W, D_MODEL), SB_W ** -0.5),
        "w_out": nrm(ks[13], (L, D_MODEL, D_MODEL), D_MODEL ** -0.5),
        "norm2_g": 1.0 + nrm(ks[14], (L, D_MODEL), 0.02),
        "peer_w_query": nrm(ks[15], (L, D_MODEL, PEER_HEADS * PEER_QDIM), D_MODEL ** -0.5),
        "peer_subkeys": nrm(ks[16], (L, 2, PEER_NKEYS, PEER_QDIM // 2), (PEER_QDIM // 2) ** -0.5),
        "peer_u": nrm(ks[17], (L, PEER_N_EXPERTS, D_MODEL), D_MODEL ** -0.5),
        "peer_v": nrm(ks[18], (L, PEER_N_EXPERTS, D_MODEL), 0.5),
    }


def reference(x, norm1_g, w_in, q_norm_g, k_norm_g, cmp_pos_k, cmp_pos_v, cmp_k_w1, cmp_k_w2,
              cmp_v_w1, cmp_v_w2, w_branch_nsa, w_branch_sb, w_out, norm2_g, peer_w_query,
              peer_subkeys, peer_u, peer_v):
    h = x.astype(jnp.float32)
    for l in range(DEPTH):
        xn = rms_norm(h, norm1_g[l])
        h = h + token_mixers(xn, w_in[l], q_norm_g[l], k_norm_g[l], cmp_pos_k[l], cmp_pos_v[l],
                             cmp_k_w1[l], cmp_k_w2[l], cmp_v_w1[l], cmp_v_w2[l],
                             w_branch_nsa[l], w_branch_sb[l], w_out[l])
        hn = rms_norm(h, norm2_g[l])
        h = h + peer(hn, peer_w_query[l], peer_subkeys[l], peer_u[l], peer_v[l])
    return h.astype(x.dtype)
```

```cpp
#include <hip/hip_runtime.h>
#include <cstdio>
#include <cstdint>
#include <cmath>

constexpr int HU_MAX = 4;
namespace pg8 {
#define PG8_LAS __attribute__((address_space(3)))
typedef unsigned short bf16_t;
typedef short bf16x8 __attribute__((ext_vector_type(8)));
typedef float f32x4 __attribute__((ext_vector_type(4)));
typedef unsigned u32x4 __attribute__((ext_vector_type(4)));
typedef int i32x4 __attribute__((ext_vector_type(4)));
constexpr int BM = 256, BK = 64, HALF = 128, HTB = HALF * BK * 2  , STAGE_BYTES = 8 * HTB, NXCD = 8, WGM = 8;

__host__ __device__ __forceinline__ int lds_byte(int r, int c) { const int st = (r >> 4) * 2 + (c >> 5), rr = r & 15, cc = c & 31, ob = rr * 64 + cc * 2; return st * 1024 + (ob ^ (((ob >> 9) & 1) << 5)); }
__host__ __device__ __forceinline__ void stage_rc(int b, int& R, int& C) { const int st = b / 1024, sb = b % 1024, swz = sb ^ (((sb >> 9) & 1) << 5); R = (st >> 1) * 16 + swz / 64; C = (st & 1) * 32 + (swz % 64) / 2; }
__host__ __device__ __forceinline__ int perm32(int rho) { const int n = rho >> 4, i = rho & 15; return 8 * (i >> 2) + 4 * n + (i & 3); }

struct Unit { int pm, pn; };
struct Gemm { const bf16_t* A; const bf16_t* Bt; int M, N, K, lda, ldb; };

struct StaticOrder {
    int nM, nN, nwg, G, c;
    __host__ __device__ void init(int M, int N, int G_, int c_) { nM = M / BM; nN = N / BM; nwg = nM * nN; G = G_; c = c_; }
    __host__ __device__ bool next(int i, Unit& u) const {
        const long L = (long)i * G + c; if (L >= nwg) return false;
        int wgid = (int)L; { const int q = nwg / NXCD, r = nwg % NXCD, xcd = wgid % NXCD, off = wgid / NXCD; wgid = (xcd < r ? xcd * (q + 1) : r * (q + 1) + (xcd - r) * q) + off; }
        const int nig = WGM * nN, gid = wgid / nig, fm = gid * WGM, gsz = (nM - fm) < WGM ? (nM - fm) : WGM;
        u.pm = fm + ((wgid % nig) % gsz); u.pn = (wgid % nig) / gsz; return true;
    }
    __device__ __forceinline__ void a_ready(const Unit&) const {}
    __device__ __forceinline__ void done(const Unit&) const {}
};

typedef float f32x2_cv __attribute__((ext_vector_type(2))); typedef __bf16 bf16x2_cv __attribute__((ext_vector_type(2)));
__device__ __forceinline__ unsigned cvt_pk_bf16(float lo, float hi) { const f32x2_cv v = {lo, hi}; const bf16x2_cv b = __builtin_convertvector(v, bf16x2_cv); return __builtin_bit_cast(unsigned, b); }
template <class F> struct EpiP8 {
    static constexpr bool PERM = true, AFTER_DRAIN = false; F f;
    __device__ __forceinline__ void operator()(const f32x4 (&acc)[2][2][4][2], const Unit& u, int wr, int wc, int fr, int fq) const {
        const int row0 = u.pm * BM + wr * 64 + fr, col0 = u.pn * BM + wc * 32 + 8 * fq;
#pragma unroll
        for (int ai = 0; ai < 2; ++ai)
#pragma unroll
            for (int m = 0; m < 4; ++m)
#pragma unroll
                for (int bj = 0; bj < 2; ++bj) f(row0 + ai * HALF + m * 16, col0 + bj * HALF, acc[ai][bj][m][0], acc[ai][bj][m][1], u);
    }
};
template <class F> struct EpiN4 {
    static constexpr bool PERM = false, AFTER_DRAIN = false; F f;
    __device__ __forceinline__ void operator()(const f32x4 (&acc)[2][2][4][2], const Unit& u, int wr, int wc, int fr, int fq) const {
        const int row0 = u.pm * BM + wr * 64 + fr, col0 = u.pn * BM + wc * 32 + 4 * fq;
#pragma unroll
        for (int ai = 0; ai < 2; ++ai)
#pragma unroll
            for (int m = 0; m < 4; ++m)
#pragma unroll
                for (int bj = 0; bj < 2; ++bj)
#pragma unroll
                    for (int n = 0; n < 2; ++n) f(row0 + ai * HALF + m * 16, col0 + bj * HALF + n * 16, acc[ai][bj][m][n], u);
    }
};
struct ListOrder {
    int n, div, G, c;
    __device__ bool next(int i, Unit& u) const { const int L = i * G + c; if (L >= n) return false; u.pm = L; u.pn = L / div; return true; }
    __device__ __forceinline__ void a_ready(const Unit&) const {}
    __device__ __forceinline__ void done(const Unit&) const {}
};

template <class Epi, class Sched, bool ALIGN_EPI = false, bool SP2 = false, bool F8 = false>
__device__ __forceinline__ void gemm_phase(PG8_LAS unsigned char* lds, const Gemm g, const Sched& S, const Epi& E) {
    const int tid = threadIdx.x, wid = __builtin_amdgcn_readfirstlane(tid >> 6), lane = tid & 63, wr = wid >> 2, wc = wid & 3, fr = lane & 15, fq = lane >> 4;
    const int K = g.K, nt = K / BK;
    unsigned voffA[2], voffB[2];
#pragma unroll
    for (int i = 0; i < 2; ++i) { int R, C; stage_rc(tid * 16 + i * 8192, R, C); const int Rb = Epi::PERM ? ((R & ~31) + perm32(R & 31)) : R;
        voffA[i] = (unsigned)(R * g.lda + C) * 2u; voffB[i] = (unsigned)(Rb * g.ldb + C) * 2u; }
    const size_t kstep = (size_t)(BK * 2);
    const size_t hstepA = (size_t)HALF * g.lda * 2, hstepB = (size_t)HALF * g.ldb * 2;
    const size_t tstepA = 2 * hstepA, tstepB = 2 * hstepB;
    const unsigned ldsw = (unsigned)wid * 1024u;
    const int aoff = lds_byte(wr * 64 + fr, fq * 8), boff = lds_byte(wc * 32 + fr, fq * 8);
#define PG8_SA(b, h) (((b) * 2 + (h)) * HTB)
#define PG8_SB(b, h) ((4 + (b) * 2 + (h)) * HTB)
#define PG8_STAGE(bufoff, gbase, voff) do { _Pragma("unroll") for (int _i = 0; _i < 2; ++_i) \
        __builtin_amdgcn_global_load_lds((const unsigned*)((const char*)(gbase) + (voff)[_i]), (PG8_LAS unsigned*)(lds + (bufoff) + ldsw + _i * 8192), 16, 0, 0); } while (0)
#define PG8_LDA(dst, b, h) do { _Pragma("unroll") for (int m = 0; m < 4; ++m) _Pragma("unroll") for (int k = 0; k < 2; ++k) dst[m][k] = *(const PG8_LAS bf16x8*)(lds + PG8_SA(b, h) + aoff + m * 2048 + k * 1024); } while (0)
#define PG8_LDB(dst, b, h) do { _Pragma("unroll") for (int n = 0; n < 2; ++n) _Pragma("unroll") for (int k = 0; k < 2; ++k) dst[n][k] = *(const PG8_LAS bf16x8*)(lds + PG8_SB(b, h) + boff + n * 2048 + k * 1024); } while (0)
#define PG8_CAT8(x, y) __builtin_shufflevector(__builtin_bit_cast(i32x4, (x)), __builtin_bit_cast(i32x4, (y)), 0, 1, 2, 3, 4, 5, 6, 7)
#define PG8_MMA(ai, bj, At, Bt) do { __builtin_amdgcn_s_setprio(1); if constexpr (F8) { _Pragma("unroll") for (int m = 0; m < 4; ++m) _Pragma("unroll") for (int n = 0; n < 2; ++n) \
        asm volatile("v_mfma_f32_16x16x128_f8f6f4 %0, %1, %2, %0" : "+v"(acc[ai][bj][m][n]) : "v"(PG8_CAT8(Bt[n][0], Bt[n][1])), "v"(PG8_CAT8(At[m][0], At[m][1]))); } else {     \
        _Pragma("unroll") for (int m = 0; m < 4; ++m) _Pragma("unroll") for (int n = 0; n < 2; ++n) _Pragma("unroll") for (int k = 0; k < 2; ++k) \
        acc[ai][bj][m][n] = __builtin_amdgcn_mfma_f32_16x16x32_bf16(Bt[n][k], At[m][k], acc[ai][bj][m][n], 0, 0, 0); } __builtin_amdgcn_s_setprio(0); } while (0)
#define PG8_WAIT_V(n) asm volatile("s_waitcnt vmcnt(" #n ")" ::: "memory")
#define PG8_WAIT_L(n) asm volatile("s_waitcnt lgkmcnt(" #n ")" ::: "memory")
#define PG8_BAR __builtin_amdgcn_s_barrier()
#define PG8_SCHED __builtin_amdgcn_sched_barrier(0)
    Unit cur, nxt; int ui = 0;
    if (!S.next(0, cur)) return;
    f32x4 acc[2][2][4][2];
#pragma unroll
    for (int a = 0; a < 2; ++a)
#pragma unroll
        for (int b = 0; b < 2; ++b)
#pragma unroll
            for (int m = 0; m < 4; ++m)
#pragma unroll
                for (int n = 0; n < 2; ++n) acc[a][b][m][n] = (f32x4){0.f, 0.f, 0.f, 0.f};
    bf16x8 At[4][2], B0[2][2], B1[2][2];
    const char* cA = (const char*)g.A + (size_t)cur.pm * tstepA; const char* cB = (const char*)g.Bt + (size_t)cur.pn * tstepB;
    S.a_ready(cur);
    if constexpr (SP2) {
        PG8_STAGE(PG8_SB(0, 0), cB, voffB); PG8_STAGE(PG8_SB(0, 1), cB + hstepB, voffB); PG8_STAGE(PG8_SA(0, 0), cA, voffA); PG8_STAGE(PG8_SA(0, 1), cA + hstepA, voffA);
        if (wr == 1) PG8_BAR;
        PG8_WAIT_V(2); PG8_BAR;
        PG8_STAGE(PG8_SB(1, 0), cB + kstep, voffB); PG8_STAGE(PG8_SA(1, 0), cA + kstep, voffA); PG8_STAGE(PG8_SB(1, 1), cB + hstepB + kstep, voffB);
        PG8_WAIT_V(6); PG8_BAR;
    } else {
        PG8_STAGE(PG8_SB(0, 0), cB, voffB); PG8_STAGE(PG8_SA(0, 0), cA, voffA); PG8_STAGE(PG8_SB(0, 1), cB + hstepB, voffB); PG8_STAGE(PG8_SA(0, 1), cA + hstepA, voffA);
        if (wr == 1) PG8_BAR;
        PG8_WAIT_V(4); PG8_BAR;
        PG8_STAGE(PG8_SB(1, 0), cB + kstep, voffB); PG8_STAGE(PG8_SA(1, 0), cA + kstep, voffA); PG8_STAGE(PG8_SB(1, 1), cB + hstepB + kstep, voffB);
        PG8_WAIT_V(6); PG8_BAR;
    }
    for (;;) {
        const bool has_next = S.next(ui + 1, nxt);
        const char* nA = has_next ? (const char*)g.A + (size_t)nxt.pm * tstepA : cA; const char* nB = has_next ? (const char*)g.Bt + (size_t)nxt.pn * tstepB : cB;
#pragma nounroll
        for (int t = 0; t < nt; t += 2) {
            const bool last = (t == nt - 2);
            const char* a1 = cA + (size_t)(t + 1) * kstep;
            const char* a2 = last ? nA : cA + (size_t)(t + 2) * kstep; const char* b2 = last ? nB : cB + (size_t)(t + 2) * kstep;
            const char* a3 = a2 + kstep; const char* b3 = b2 + kstep;
            if (last && has_next) S.a_ready(nxt);
            if constexpr (SP2) {
            PG8_LDB(B0, 0, 0); PG8_LDB(B1, 0, 1); PG8_SCHED; PG8_LDA(At, 0, 0); PG8_STAGE(PG8_SA(1, 1), a1 + hstepA, voffA);
            PG8_WAIT_V(8); PG8_WAIT_L(0); PG8_BAR; PG8_MMA(0, 0, At, B0); PG8_MMA(0, 1, At, B1); PG8_BAR; PG8_SCHED;
            PG8_LDA(At, 0, 1); PG8_STAGE(PG8_SB(0, 0), b2, voffB); PG8_STAGE(PG8_SB(0, 1), b2 + hstepB, voffB); PG8_STAGE(PG8_SA(0, 0), a2, voffA);
            PG8_WAIT_V(8); PG8_WAIT_L(0); PG8_BAR; PG8_MMA(1, 0, At, B0); PG8_MMA(1, 1, At, B1); PG8_BAR; PG8_SCHED;
            PG8_LDB(B0, 1, 0); PG8_LDB(B1, 1, 1); PG8_SCHED; PG8_LDA(At, 1, 0); PG8_STAGE(PG8_SA(0, 1), a2 + hstepA, voffA);
            PG8_WAIT_V(8); PG8_WAIT_L(0); PG8_BAR; PG8_MMA(0, 0, At, B0); PG8_MMA(0, 1, At, B1); PG8_BAR; PG8_SCHED;
            PG8_LDA(At, 1, 1); PG8_STAGE(PG8_SB(1, 0), b3, voffB); PG8_STAGE(PG8_SB(1, 1), b3 + hstepB, voffB); PG8_STAGE(PG8_SA(1, 0), a3, voffA);
            PG8_WAIT_V(8); PG8_WAIT_L(0); PG8_BAR; PG8_MMA(1, 0, At, B0); PG8_MMA(1, 1, At, B1); PG8_BAR; PG8_SCHED;
            } else {
            PG8_LDB(B0, 0, 0); PG8_SCHED; PG8_LDA(At, 0, 0); PG8_STAGE(PG8_SA(1, 1), a1 + hstepA, voffA);
            PG8_WAIT_L(8); PG8_BAR; PG8_WAIT_L(0); PG8_MMA(0, 0, At, B0); PG8_BAR; PG8_SCHED;
            PG8_LDB(B1, 0, 1); PG8_STAGE(PG8_SB(0, 0), b2, voffB);
            PG8_BAR; PG8_WAIT_L(0); PG8_MMA(0, 1, At, B1); PG8_BAR;
            PG8_LDA(At, 0, 1); PG8_STAGE(PG8_SA(0, 0), a2, voffA);
            PG8_BAR; PG8_WAIT_L(0); PG8_MMA(1, 0, At, B0); PG8_BAR; PG8_SCHED;
            PG8_STAGE(PG8_SB(0, 1), b2 + hstepB, voffB);
            PG8_WAIT_V(6); PG8_BAR; PG8_MMA(1, 1, At, B1); PG8_BAR;
            PG8_LDB(B0, 1, 0); PG8_SCHED; PG8_LDA(At, 1, 0); PG8_STAGE(PG8_SA(0, 1), a2 + hstepA, voffA);
            PG8_WAIT_L(8); PG8_BAR; PG8_WAIT_L(0); PG8_MMA(0, 0, At, B0); PG8_BAR; PG8_SCHED;
            PG8_LDB(B1, 1, 1); PG8_STAGE(PG8_SB(1, 0), b3, voffB);
            PG8_BAR; PG8_WAIT_L(0); PG8_MMA(0, 1, At, B1); PG8_BAR;
            PG8_LDA(At, 1, 1); PG8_STAGE(PG8_SA(1, 0), a3, voffA);
            PG8_BAR; PG8_WAIT_L(0); PG8_MMA(1, 0, At, B0); PG8_BAR; PG8_SCHED;
            PG8_STAGE(PG8_SB(1, 1), b3 + hstepB, voffB);
            PG8_WAIT_V(6); PG8_BAR; PG8_MMA(1, 1, At, B1); PG8_BAR;
            }
        }
        if constexpr (F8) { asm volatile("s_nop 15\n\ts_nop 15" ::: "memory"); }
        if constexpr (ALIGN_EPI) { if (wr == 0) PG8_BAR; }
        if constexpr (!Epi::AFTER_DRAIN) { E(acc, cur, wr, wc, fr, fq); S.done(cur); }
        if (!has_next) break;
#pragma unroll
        for (int a = 0; a < 2; ++a)
#pragma unroll
            for (int b = 0; b < 2; ++b)
#pragma unroll
                for (int m = 0; m < 4; ++m)
#pragma unroll
                    for (int n = 0; n < 2; ++n) acc[a][b][m][n] = (f32x4){0.f, 0.f, 0.f, 0.f};
        cur = nxt; cA = nA; cB = nB; ++ui;
        if constexpr (ALIGN_EPI) { if (wr == 1) PG8_BAR; }
    }
    PG8_WAIT_V(0);
    if constexpr (!ALIGN_EPI) { if (wr == 0) PG8_BAR; }
    PG8_BAR;
    if constexpr (Epi::AFTER_DRAIN) { E.fused(acc, cur, wr, wc, fr, fq, lds, wid, lane); S.done(cur); }
#undef PG8_SA
#undef PG8_SB
#undef PG8_STAGE
#undef PG8_LDA
#undef PG8_LDB
#undef PG8_MMA
#undef PG8_CAT8
#undef PG8_WAIT_V
#undef PG8_WAIT_L
#undef PG8_BAR
#undef PG8_SCHED
}
}

constexpr int NWAVES = 8;
constexpr int M_TOK = 16384, SEQ = 8192, DM = 1024;
constexpr int PJ = 2816;
constexpr int N1 = 5120;
constexpr int N_PROJ = 2816;
constexpr size_t XN8_OFF = (size_t)32 << 20;
constexpr int C_KV = 512, C_SB = 1280;
constexpr float EPS = 1e-6f;

constexpr size_t MiB = 1u << 20;
constexpr size_t WS_PROJ = 0;
constexpr size_t WS_QP = 96 * MiB;
constexpr size_t WS_ROPE = 88 * MiB;
constexpr size_t WS_GN = 90 * MiB;
constexpr size_t WS_SEL = 92 * MiB;
constexpr size_t WS_KC = 94 * MiB;
constexpr size_t WS_VC = 94 * MiB + 512 * 1024;
constexpr size_t WS_BIAS = 95 * MiB;
constexpr size_t WS_KC16 = 95 * MiB + 65536, WS_VC16 = WS_KC16 + 262144;
constexpr size_t WS_GATE = 96 * MiB;
constexpr size_t WS_U16 = 96 * MiB, WS_V16 = 128 * MiB;
constexpr size_t WS_U8 = 192 * MiB, WS_V8 = 208 * MiB, WS_SU = 255 * MiB + 655360, WS_SVS = 255 * MiB + 720896;
constexpr size_t WS_PL = 64 * MiB;
constexpr size_t WS_PLR = 72 * MiB, WS_OFF = 80 * MiB, WS_HF8 = 160 * MiB;
constexpr size_t WS_ROWSS = 82 * MiB;
constexpr size_t WS_SH = 81 * MiB;
constexpr int CW_NEXC = 96, CW_EXC = 8192, EXC_CAP = 4096;
constexpr int CW_XR = 128;
constexpr size_t WS_W2T = 93 * MiB + 131072;
constexpr size_t WS_SK16 = 93 * MiB;
constexpr size_t WS_ONSA = 160 * MiB, WS_OSB = 176 * MiB;
constexpr size_t WS_D = 192 * MiB;
constexpr size_t WS_KCVC = WS_D, WS_H = WS_D + 10 * MiB;
constexpr size_t WS_M8 = 64 * MiB;
constexpr size_t WS_MERGED = 0, WS_HN = 32 * MiB;
constexpr size_t WS_WIN8 = 230 * MiB;
constexpr size_t WS_WIN = 224 * MiB, WS_WA = 234 * MiB, WS_WB = 235 * MiB, WS_WO = 236 * MiB, WS_WQ = 238 * MiB, WS_W1 = 242 * MiB;
constexpr size_t WS_CTL = 255 * MiB, CTL_ZERO_BYTES = 1 * MiB;
constexpr int CW_BAR = 4096;
constexpr int CW_CHK = 64;
constexpr float QSCALE = 0.125f * 1.4426950408889634f;

constexpr int RING_OFF = 0, RING_BYTES = 131072;
constexpr int LDSCTL_OFF = 150528, MISC_OFF = LDSCTL_OFF + 320;
constexpr int LDS_BYTES = 151552;

#define GAS __attribute__((address_space(1)))
#define LAS __attribute__((address_space(3)))
typedef unsigned short bf16;
typedef unsigned v4u __attribute__((ext_vector_type(4)));
typedef unsigned v2u __attribute__((ext_vector_type(2)));
typedef float f32x4 __attribute__((ext_vector_type(4)));
typedef GAS unsigned gu32;
#define RLX_AGENT __ATOMIC_RELAXED, __HIP_MEMORY_SCOPE_AGENT
#define LDS_WAIT() asm volatile("s_waitcnt lgkmcnt(0)" ::: "memory")
__device__ __forceinline__ unsigned f2bf(float f) { unsigned u = __builtin_bit_cast(unsigned, f); return (u + 0x7fffu + ((u >> 16) & 1u)) >> 16; }
__device__ __forceinline__ unsigned pk2(float lo, float hi) { return f2bf(lo) | (f2bf(hi) << 16); }
__device__ __forceinline__ float bf2f(unsigned h) { return __builtin_bit_cast(float, h << 16); }
__device__ __forceinline__ float bflo(unsigned w) { return __builtin_bit_cast(float, w << 16); }
__device__ __forceinline__ float bfhi(unsigned w) { return __builtin_bit_cast(float, w & 0xffff0000u); }
__device__ __forceinline__ unsigned pack4_fp8(float x0, float x1, float x2, float x3) { int w = __builtin_amdgcn_cvt_pk_fp8_f32(x0, x1, 0, false); w = __builtin_amdgcn_cvt_pk_fp8_f32(x2, x3, w, true); return (unsigned)w; }

#define XL_DPP(v_, ctrl_) __uint_as_float((unsigned)__builtin_amdgcn_update_dpp(0, (int)__float_as_uint(v_), (ctrl_), 0xF, 0xF, true))
__device__ __forceinline__ float xl_swap16(float v) { const auto r = __builtin_amdgcn_permlane16_swap(__float_as_uint(v), __float_as_uint(v), false, false); return __uint_as_float(r[0]) + __uint_as_float(r[1]); }
__device__ __forceinline__ float xl_swap32(float v) { const auto r = __builtin_amdgcn_permlane32_swap(__float_as_uint(v), __float_as_uint(v), false, false); return __uint_as_float(r[0]) + __uint_as_float(r[1]); }
__device__ __forceinline__ float xl_xor32(float v, int lane) { const auto r = __builtin_amdgcn_permlane32_swap(__float_as_uint(v), __float_as_uint(v), false, false); return __uint_as_float(lane < 32 ? r[1] : r[0]); }
__device__ __forceinline__ float xl_max16(float v) { const auto r = __builtin_amdgcn_permlane16_swap(__float_as_uint(v), __float_as_uint(v), false, false); return fmaxf(__uint_as_float(r[0]), __uint_as_float(r[1])); }
__device__ __forceinline__ float xl_max32(float v) { const auto r = __builtin_amdgcn_permlane32_swap(__float_as_uint(v), __float_as_uint(v), false, false); return fmaxf(__uint_as_float(r[0]), __uint_as_float(r[1])); }
__device__ __forceinline__ float quad_sum(float v) { v += XL_DPP(v, 0xB1); v += XL_DPP(v, 0x4E); return v; }
__device__ __forceinline__ float row_sum(float v) { v = quad_sum(v); v += XL_DPP(v, 0x141); v += XL_DPP(v, 0x128); return v; }
__device__ __forceinline__ float row_max(float v) { v = fmaxf(v, XL_DPP(v, 0xB1)); v = fmaxf(v, XL_DPP(v, 0x4E)); v = fmaxf(v, XL_DPP(v, 0x141)); v = fmaxf(v, XL_DPP(v, 0x128)); return v; }

#define XB_TMO      128
#define XB_XCNT(j)  (256  + 64 * (j))
#define XB_XSUB(j)  (1280 + 64 * (j))
#define XB_XGEN(j)  (2304 + 64 * (j))
#define XB_TOP      3328
#define XB_TOPGEN   3392
#define XCD_BAR_WORDS 3456
#define XB_SPIN_CAP (1u << 24)

__device__ __forceinline__ unsigned xb_ld(unsigned* p)              { return __hip_atomic_load(p, __ATOMIC_RELAXED, __HIP_MEMORY_SCOPE_AGENT); }
__device__ __forceinline__ unsigned xb_add(unsigned* p, unsigned v) { return __hip_atomic_fetch_add(p, v, __ATOMIC_RELAXED, __HIP_MEMORY_SCOPE_AGENT); }
__device__ __forceinline__ unsigned xb_xcc_id() { return (unsigned)__builtin_amdgcn_s_getreg((3 << 11) | 20) & 0xFu; }
#define XB_SPIN(cond, bar) do { unsigned _sp = 0; while (cond) { __builtin_amdgcn_s_sleep(1); \
    if ((++_sp & 255u) == 0u) { if (xb_ld(&(bar)[XB_TMO])) break; if (_sp > XB_SPIN_CAP) { atomicAdd(&(bar)[XB_TMO], 1u); break; } } } } while (0)

struct XcdBarrier {
    unsigned* bar; unsigned x;
    volatile LAS unsigned* st;
};

__device__ __forceinline__ XcdBarrier xcd_barrier_post(unsigned* bar, volatile LAS unsigned* st) {
    XcdBarrier b; b.bar = bar; b.x = xb_xcc_id(); b.st = st;
    if (threadIdx.x == 0) (void)xb_add(&bar[XB_XCNT(b.x)], 1u);
    return b;
}
__device__ __forceinline__ void xcd_barrier_complete(unsigned* bar, unsigned x, unsigned& nloc, unsigned& nx) {
    const unsigned G = gridDim.x * gridDim.y * gridDim.z;
    unsigned sum, cnt, mine, sp = 0u;
    for (;;) {
        sum = 0u; cnt = 0u; mine = 0u;
#pragma unroll
        for (unsigned j = 0; j < 16; ++j) { const unsigned c = xb_ld(&bar[XB_XCNT(j)]); sum += c; cnt += (c > 0u) ? 1u : 0u; mine = (j == x) ? c : mine; }
        if (sum == G) break;
        __builtin_amdgcn_s_sleep(1);
        if ((++sp & 255u) == 0u) { if (xb_ld(&bar[XB_TMO])) break; if (sp > XB_SPIN_CAP) { atomicAdd(&bar[XB_TMO], 1u); break; } }
    }
    nloc = mine > 0u ? mine : 1u; nx = cnt > 0u ? cnt : 1u;
}

__device__ __forceinline__ void xcd_barrier(const XcdBarrier& b) {
    asm volatile("s_waitcnt vmcnt(0)" ::: "memory");
    __syncthreads();
    if (threadIdx.x == 0) {
        unsigned* bar = b.bar;
        __builtin_amdgcn_s_waitcnt(0);
        unsigned nloc = b.st[0], nx = b.st[1];
        if (nloc == 0u) { xcd_barrier_complete(bar, b.x, nloc, nx); b.st[0] = nloc; b.st[1] = nx; }
        const unsigned old = xb_add(&bar[XB_XSUB(b.x)], 1u);
        const unsigned gen = old / nloc;
        if (old + 1u == (gen + 1u) * nloc) {
            __builtin_amdgcn_fence(__ATOMIC_RELEASE, "agent");
            asm volatile("s_waitcnt vmcnt(0)" ::: "memory");
            const unsigned og = xb_add(&bar[XB_TOP], 1u);
            const unsigned tg = og / nx;
            if (og + 1u == (tg + 1u) * nx) xb_add(&bar[XB_TOPGEN], 1u);
            else XB_SPIN(xb_ld(&bar[XB_TOPGEN]) == tg, bar);
            __builtin_amdgcn_fence(__ATOMIC_ACQUIRE, "agent");
            xb_add(&bar[XB_XGEN(b.x)], 1u);
            asm volatile("s_waitcnt vmcnt(0)" ::: "memory");
        } else {
            XB_SPIN(xb_ld(&bar[XB_XGEN(b.x)]) == gen, bar);
            __builtin_amdgcn_fence(__ATOMIC_ACQUIRE, "agent");
            asm volatile("s_waitcnt vmcnt(0)" ::: "memory");
        }
    }
    __syncthreads();
}

struct Args {
    const float* in[19];
    float* out; unsigned char* ws;
    int ph_lo, ph_hi;
};

__device__ const float ROPE_FREQ[32] = {
    1.000000000e+00f, 7.498942018e-01f, 5.623413324e-01f, 4.216965139e-01f, 3.162277639e-01f, 2.371373773e-01f, 1.778279394e-01f, 1.333521456e-01f, 1.000000015e-01f, 7.498942316e-02f, 5.623413250e-02f, 4.216964915e-02f, 3.162277490e-02f, 2.371373773e-02f, 1.778279431e-02f, 1.333521400e-02f, 9.999999776e-03f, 7.498942316e-03f, 5.623413250e-03f, 4.216964822e-03f, 3.162277630e-03f, 2.371373819e-03f, 1.778279431e-03f, 1.333521446e-03f, 1.000000047e-03f, 7.498941850e-04f, 5.623413017e-04f, 4.216965172e-04f, 3.162277571e-04f, 2.371373703e-04f, 1.778279402e-04f, 1.333521504e-04f};
struct Ctx {
    int tid, lane, wave, G, bid;
    LAS unsigned char* lds;
};

__device__ __forceinline__ float wave_sum(float v) { return xl_swap32(xl_swap16(row_sum(v))); }
__device__ __forceinline__ float wave_max(float v) { return xl_max32(xl_max16(row_max(v))); }
__device__ __forceinline__ float gelu_tanh(float x) { const float y = 0.7978845608028654f * (x + 0.044715f * x * x * x); return x * __builtin_amdgcn_rcpf(1.f + __builtin_amdgcn_exp2f(-2.8853900817779268f * y)); }
__device__ __forceinline__ float sigmoid_f(float x) { return __builtin_amdgcn_rcpf(1.f + __builtin_amdgcn_exp2f(-1.4426950408889634f * x)); }
__device__ __forceinline__ int win_map(int n) {
    if (n < 1280) return n;
    if (n < 2816) return 1304 + (n - 1280);
    if (n < 4864) return 2840 + (n - 2816);
    if (n < 4888) return 1280 + (n - 4864);
    return -1;
}
template <bool MAP, int F8S = 0> __device__ __forceinline__ void p0_transpose_item(const float* W, int K, int N, int NP, bf16* WT, int row_off, LAS float* scr, int item, int lane) {
    const int nblk = NP / 32, kb = item / nblk, nb = item % nblk, k0 = 64 * kb, n0 = 32 * nb;
    int col = n0 + (lane & 31); if (MAP) col = win_map(col);
    float tv[32];
#pragma unroll
    for (int i = 0; i < 32; ++i) { const int kk = 2 * i + (lane >> 5); tv[i] = col >= 0 ? W[(size_t)(k0 + kk) * N + col] : 0.f; }
#pragma unroll
    for (int i = 0; i < 32; ++i) { const int kk = 2 * i + (lane >> 5); scr[kk * 33 + (lane & 31)] = tv[i]; }
    LDS_WAIT(); asm volatile("" ::: "memory");
    const int c = lane & 7;
#pragma unroll
    for (int j = 0; j < 4; ++j) { const int n = (lane >> 3) + 8 * j; const LAS float* s = scr + (8 * c) * 33 + n;
        if constexpr (F8S != 0) { const float sc = (float)F8S; v2u o; o.x = pack4_fp8(s[0 * 33] * sc, s[1 * 33] * sc, s[2 * 33] * sc, s[3 * 33] * sc); o.y = pack4_fp8(s[4 * 33] * sc, s[5 * 33] * sc, s[6 * 33] * sc, s[7 * 33] * sc);
            *(GAS v2u*)((unsigned char*)WT + (size_t)(row_off + n0 + n) * K + k0 + 8 * c) = o; }
        else {
        v4u o; o.x = pk2(s[0 * 33], s[1 * 33]); o.y = pk2(s[2 * 33], s[3 * 33]); o.z = pk2(s[4 * 33], s[5 * 33]); o.w = pk2(s[6 * 33], s[7 * 33]);
        *(GAS v4u*)(WT + (size_t)(row_off + n0 + n) * K + k0 + 8 * c) = o; } }
    LDS_WAIT(); asm volatile("" ::: "memory");
}
template <int NR> __device__ __forceinline__ void rms_rows_to_bf16(const float* x0, size_t xstride, const float* gain, bf16* o0, size_t ostride, int lane, unsigned char* f8 = nullptr) {
    f32x4 v[NR][4]; float s2[NR];
#pragma unroll
    for (int k = 0; k < NR; ++k) { const f32x4* xr = (const f32x4*)(x0 + (size_t)k * xstride) + lane; s2[k] = 0.f;
#pragma unroll
        for (int j = 0; j < 4; ++j) v[k][j] = xr[64 * j]; }
#pragma unroll
    for (int k = 0; k < NR; ++k)
#pragma unroll
        for (int j = 0; j < 4; ++j) s2[k] += (v[k][j].x * v[k][j].x + v[k][j].y * v[k][j].y) + (v[k][j].z * v[k][j].z + v[k][j].w * v[k][j].w);
#pragma unroll
    for (int k = 0; k < NR; ++k) s2[k] = wave_sum(s2[k]);
    const f32x4* gr = (const f32x4*)gain + lane;
#pragma unroll
    for (int k = 0; k < NR; ++k) { const float r = 1.f / sqrtf(s2[k] * (1.f / 1024.f) + EPS); unsigned long long* o8 = (unsigned long long*)(o0 + (size_t)k * ostride) + lane;
#pragma unroll
        for (int j = 0; j < 4; ++j) { const f32x4 g = gr[64 * j];
            o8[64 * j] = (unsigned long long)pk2(v[k][j].x * r * g.x, v[k][j].y * r * g.y) | ((unsigned long long)pk2(v[k][j].z * r * g.z, v[k][j].w * r * g.w) << 32);
            if (f8) ((unsigned*)(f8 + (size_t)k * ostride))[lane + 64 * j] = pack4_fp8(v[k][j].x * r * g.x, v[k][j].y * r * g.y, v[k][j].z * r * g.z, v[k][j].w * r * g.w); } }
}
__device__ __forceinline__ void sincos_d(double a, double& s, double& c) {
    const double kf = rint(a * 0.6366197723675814); const int k = (int)kf;
    double r = fma(-kf, 1.5707963267948966, a); r = fma(-kf, 6.123233995736766e-17, r);
    const double r2 = r * r;
    const double sp = r * (1.0 + r2 * (-1.0 / 6.0 + r2 * (1.0 / 120.0 + r2 * (-1.0 / 5040.0 + r2 * (1.0 / 362880.0 + r2 * (-1.0 / 39916800.0 + r2 * (1.0 / 6227020800.0)))))));
    const double cp = 1.0 + r2 * (-0.5 + r2 * (1.0 / 24.0 + r2 * (-1.0 / 720.0 + r2 * (1.0 / 40320.0 + r2 * (-1.0 / 3628800.0 + r2 * (1.0 / 479001600.0 + r2 * (-1.0 / 87178291200.0)))))));
    const int q = k & 3;
    s = (q == 0) ? sp : (q == 1) ? cp : (q == 2) ? -sp : -cp;
    c = (q == 0) ? cp : (q == 1) ? -sp : (q == 2) ? -cp : sp;
}

__device__ __forceinline__ void p0_prologue(const Args& a, const Ctx& X) {
    LAS float* scr = (LAS float*)(X.lds + RING_OFF + X.wave * 16384);
    const int gw = X.bid * NWAVES + X.wave, NGW = X.G * NWAVES;
    unsigned char* ws = a.ws;
    constexpr int I_IN = 16 * (N1 / 32), I_A = 8 * 32, I_B = 8 * 32, I_O = 16 * 32, I_Q = 16 * 64, I_1 = 32 * 8;
    constexpr int NITEMS = I_IN + I_A + I_B + I_O + I_Q + 2 * I_1;
    for (int it = gw; it < NITEMS; it += NGW) {
        int r = it;
        if (r < I_IN) { if (r % (N1 / 32) >= N_PROJ / 32) p0_transpose_item<true, 32>(a.in[2], 1024, 4888, N1, (bf16*)(ws + WS_WIN8), -N_PROJ, scr, r, X.lane);
            else p0_transpose_item<true>(a.in[2], 1024, 4888, N1, (bf16*)(ws + WS_WIN), 0, scr, r, X.lane); continue; } r -= I_IN;
        if (r < I_A) { p0_transpose_item<false, 32>(a.in[11], 512, 1024, 1024, (bf16*)(ws + WS_WA), 0, scr, r, X.lane); continue; } r -= I_A;
        if (r < I_B) { p0_transpose_item<false, 32>(a.in[12], 512, 1024, 1024, (bf16*)(ws + WS_WA), 1024, scr, r, X.lane); continue; } r -= I_B;
        if (r < I_O) { p0_transpose_item<false, 32>(a.in[13], 1024, 1024, 1024, (bf16*)(ws + WS_WO), 0, scr, r, X.lane); continue; } r -= I_O;
        if (r < I_Q) { p0_transpose_item<false>(a.in[15], 1024, 2048, 2048, (bf16*)(ws + WS_WQ), 0, scr, r, X.lane); continue; } r -= I_Q;
        if (r < I_1) { p0_transpose_item<false>(a.in[7], 2048, 256, 256, (bf16*)(ws + WS_W1), 0, scr, r, X.lane); continue; } r -= I_1;
        p0_transpose_item<false>(a.in[9], 2048, 256, 256, (bf16*)(ws + WS_W1), 256, scr, r, X.lane);
    }
    bf16* XN = (bf16*)a.out;
    if (M_TOK % (8 * NGW) == 0) { for (int m = gw; m < M_TOK; m += 8 * NGW) rms_rows_to_bf16<8>(a.in[0] + (size_t)m * DM, (size_t)NGW * DM, a.in[1], XN + (size_t)m * DM, (size_t)NGW * DM, X.lane, (unsigned char*)a.out + XN8_OFF + (size_t)m * DM); }
    else for (int m = gw; m < M_TOK; m += NGW) rms_rows_to_bf16<1>(a.in[0] + (size_t)m * DM, 0, a.in[1], XN + (size_t)m * DM, 0, X.lane, (unsigned char*)a.out + XN8_OFF + (size_t)m * DM);
    float2* rope = (float2*)(ws + WS_ROPE);
    for (int idx = X.bid * 512 + X.tid; idx < SEQ * 32; idx += X.G * 512) {
        const int pos = idx >> 5, i = idx & 31; const float ang = (float)pos * ROPE_FREQ[i];
        double s, c; sincos_d((double)ang, s, c); rope[idx] = make_float2((float)c, (float)s);
    }
    { bf16* w2t = (bf16*)(ws + WS_W2T); for (int i = X.bid * 512 + X.tid; i < 2 * 64 * 256; i += X.G * 512) { const int kv = i >> 14, d = (i >> 8) & 63, j = i & 255; w2t[i] = (bf16)f2bf((kv ? a.in[10] : a.in[8])[j * 64 + d]); } }
    { bf16* sk16 = (bf16*)(ws + WS_SK16); for (int i = X.bid * 512 + X.tid; i < 2 * 128 * 128; i += X.G * 512) sk16[i] = (bf16)f2bf(a.in[16][i]); }
    for (int it = gw; it < 4 * 512; it += NGW) { const int j = it & 511, q = it >> 9; const float* pe = (j < 256) ? a.in[5] : a.in[6]; const float* w1 = (j < 256) ? a.in[7] : a.in[9]; const int jj = j & 255; float s = 0.f;
#pragma unroll 8
        for (int f = q * 512 + X.lane; f < q * 512 + 512; f += 64) s += pe[f] * w1[(size_t)f * 256 + jj];
        s = wave_sum(s); if (X.lane == 0) ((float*)(ws + WS_BIAS))[q * 512 + j] = s; }
}

__device__ __forceinline__ unsigned gate_u8(float a, float b, float c, float d) {
    unsigned w = __builtin_amdgcn_cvt_pk_u8_f32(__builtin_rintf(a * 255.f), 0, 0u); w = __builtin_amdgcn_cvt_pk_u8_f32(__builtin_rintf(b * 255.f), 1, w); w = __builtin_amdgcn_cvt_pk_u8_f32(__builtin_rintf(c * 255.f), 2, w); return __builtin_amdgcn_cvt_pk_u8_f32(__builtin_rintf(d * 255.f), 3, w); }
struct ProjEpiF { bf16* proj; unsigned char* gate; float* gn;
    __device__ __forceinline__ void operator()(int row, int col, f32x4 v0, f32x4 v1, const pg8::Unit& u) const {
        if (u.pn < 11) { v4u w; w.x = pg8::cvt_pk_bf16(v0[0], v0[1]); w.y = pg8::cvt_pk_bf16(v0[2], v0[3]); w.z = pg8::cvt_pk_bf16(v1[0], v1[1]); w.w = pg8::cvt_pk_bf16(v1[2], v1[3]);
            *(v4u*)(proj + (size_t)row * PJ + col) = w; }
        else if (u.pn < 19) { v2u w;
            w.x = gate_u8(sigmoid_f(v0[0]), sigmoid_f(v0[1]), sigmoid_f(v0[2]), sigmoid_f(v0[3])); w.y = gate_u8(sigmoid_f(v1[0]), sigmoid_f(v1[1]), sigmoid_f(v1[2]), sigmoid_f(v1[3]));
            *(v2u*)(gate + (size_t)row * 2048 + (col - 2816)) = w; }
        else { const int c = col - 4864; if (c < 24) { float* o = gn + (size_t)row * 24 + c;
            *(f32x4*)o = (f32x4){sigmoid_f(v0[0]), sigmoid_f(v0[1]), sigmoid_f(v0[2]), sigmoid_f(v0[3])}; *(f32x4*)(o + 4) = (f32x4){sigmoid_f(v1[0]), sigmoid_f(v1[1]), sigmoid_f(v1[2]), sigmoid_f(v1[3])}; } }
    }
};
struct ProjEpiG8 { ProjEpiF f;
    __device__ __forceinline__ void operator()(int row, int col, f32x4 v0, f32x4 v1, const pg8::Unit& u) const { pg8::Unit u2 = u; u2.pn += N_PROJ / 256; f(row, col + N_PROJ, v0 * (1.f / 32.f), v1 * (1.f / 32.f), u2); }
};
struct CmpFusedEpi {
    static constexpr bool PERM = false, AFTER_DRAIN = true;
    const float* bias; const bf16* w2t; const float* kgain; const float2* rope; bf16* kc16; bf16* vc16;
    __device__ __forceinline__ void fused(pg8::f32x4 (&acc)[2][2][4][2], const pg8::Unit& u, int wr, int wc, int fr, int fq, LAS unsigned char* lds, int wid, int lane) const {
        typedef short bf16x8_t __attribute__((ext_vector_type(8)));
        const int colb = u.pn * 256;
#pragma unroll
        for (int ai = 0; ai < 2; ++ai)
#pragma unroll
            for (int m = 0; m < 4; ++m) { const int row = ai * 128 + wr * 64 + m * 16 + fr;
#pragma unroll
                for (int bj = 0; bj < 2; ++bj)
#pragma unroll
                    for (int n = 0; n < 2; ++n) { const int c0 = bj * 128 + wc * 32 + n * 16 + 4 * fq; const f32x4 b4 = (*(const f32x4*)(bias + colb + c0) + *(const f32x4*)(bias + 512 + colb + c0)) + (*(const f32x4*)(bias + 1024 + colb + c0) + *(const f32x4*)(bias + 1536 + colb + c0)); const f32x4 v = acc[ai][bj][m][n] + b4;
                        v2u w; w.x = pg8::cvt_pk_bf16(gelu_tanh(v[0]), gelu_tanh(v[1])); w.y = pg8::cvt_pk_bf16(gelu_tanh(v[2]), gelu_tanh(v[3]));
                        *(LAS v2u*)(lds + row * 512 + (((c0 >> 3) ^ (row & 15)) << 4) + ((c0 >> 2) & 1) * 8) = w; } }
        asm volatile("s_waitcnt lgkmcnt(0)" ::: "memory"); __builtin_amdgcn_s_barrier(); asm volatile("" ::: "memory");
        const int g4 = lane >> 4, cl = lane & 15, kv = u.pn; const bf16* W = w2t + (size_t)kv * 64 * 256;
        f32x4 D[2][4];
#pragma unroll
        for (int rt = 0; rt < 2; ++rt)
#pragma unroll
            for (int dt = 0; dt < 4; ++dt) D[rt][dt] = (f32x4){0.f, 0.f, 0.f, 0.f};
#pragma unroll
        for (int ks = 0; ks < 8; ++ks) { bf16x8_t aa[2], bb[4];
#pragma unroll
            for (int rt = 0; rt < 2; ++rt) aa[rt] = *(const LAS bf16x8_t*)(lds + (32 * wid + 16 * rt + cl) * 512 + (((4 * ks + g4) ^ cl) << 4));
#pragma unroll
            for (int dt = 0; dt < 4; ++dt) bb[dt] = *(const bf16x8_t*)(W + (size_t)(16 * dt + cl) * 256 + 32 * ks + 8 * g4);
#pragma unroll
            for (int rt = 0; rt < 2; ++rt)
#pragma unroll
                for (int dt = 0; dt < 4; ++dt) D[rt][dt] = __builtin_amdgcn_mfma_f32_16x16x32_bf16(aa[rt], bb[dt], D[rt][dt], 0, 0, 0); }
#pragma unroll
        for (int rt = 0; rt < 2; ++rt)
#pragma unroll
            for (int r = 0; r < 4; ++r) { const int row = u.pm * 256 + 32 * wid + 16 * rt + 4 * g4 + r, rr = row & 2047, c = rr & 511;
                float v[4] = {D[rt][0][r], D[rt][1][r], D[rt][2][r], D[rt][3][r]};
                if (kv == 0) { float ss = (v[0] * v[0] + v[1] * v[1]) + (v[2] * v[2] + v[3] * v[3]);
                    ss += __shfl_xor(ss, 1); ss += __shfl_xor(ss, 2); ss += __shfl_xor(ss, 4); ss += __shfl_xor(ss, 8);
                    const float rs = 1.f / sqrtf(ss * (1.f / 64.f) + EPS); float y[4];
#pragma unroll
                    for (int dt = 0; dt < 4; ++dt) y[dt] = v[dt] * rs * kgain[16 * dt + cl];
                    const float2 c0 = rope[(16 * min(c, 510) + 31) * 32 + cl], c1 = rope[(16 * min(c, 510) + 31) * 32 + 16 + cl];
                    v[0] = y[0] * c0.x - y[2] * c0.y; v[1] = y[1] * c1.x - y[3] * c1.y; v[2] = y[2] * c0.x + y[0] * c0.y; v[3] = y[3] * c1.x + y[1] * c1.y; }
                bf16* dst = (kv ? vc16 : kc16) + (size_t)rr * 64 + cl;
#pragma unroll
                for (int dt = 0; dt < 4; ++dt) dst[16 * dt] = (bf16)((c == 511) ? 0u : f2bf(v[dt])); }
    }
};
struct MergeEpiF { const unsigned char* gate; bf16* merged; unsigned char* m8;
    __device__ __forceinline__ void operator()(int row, int col, f32x4 v, const pg8::Unit& u) const {
        v = v * (1.f / 512.f);
        if (u.pm < 64) { const unsigned g = *(const unsigned*)(gate + (size_t)row * 2048 + col); const float g0 = (float)(g & 255u) * (1.f / 255.f), g1 = (float)((g >> 8) & 255u) * (1.f / 255.f), g2 = (float)((g >> 16) & 255u) * (1.f / 255.f), g3 = (float)(g >> 24) * (1.f / 255.f);
            v2u w; w.x = pg8::cvt_pk_bf16(v[0] * g0, v[1] * g1); w.y = pg8::cvt_pk_bf16(v[2] * g2, v[3] * g3); *(v2u*)(merged + (size_t)row * DM + col) = w; }
        else { const int r2 = row - M_TOK, c2 = col - 1024; const unsigned gq = *(const unsigned*)(gate + (size_t)r2 * 2048 + 1024 + c2); const v2u t = *(const v2u*)(merged + (size_t)r2 * DM + c2);
            const float g0 = (float)(gq & 255u) * (1.f / 255.f), g1 = (float)((gq >> 8) & 255u) * (1.f / 255.f), g2 = (float)((gq >> 16) & 255u) * (1.f / 255.f), g3 = (float)(gq >> 24) * (1.f / 255.f);
            *(unsigned*)(m8 + (size_t)r2 * DM + c2) = pack4_fp8(8.f * (bflo(t.x) + v[0] * g0), 8.f * (bfhi(t.x) + v[1] * g1), 8.f * (bflo(t.y) + v[2] * g2), 8.f * (bfhi(t.y) + v[3] * g3)); } }
};
struct MergeOrder { pg8::StaticOrder S0;
    __device__ bool next(int i, pg8::Unit& u) const { if (!S0.next(i >> 1, u)) return false; if (i & 1) { u.pm += 64; u.pn += 4; } return true; }
    __device__ __forceinline__ void a_ready(const pg8::Unit&) const {}
    __device__ __forceinline__ void done(const pg8::Unit&) const {}
};
struct OutNormEpi {
    static constexpr bool PERM = false, AFTER_DRAIN = false;
    const float* x; float* h1; bf16* hb; const float* g2; float* rowss;
    __device__ __forceinline__ void operator()(const pg8::f32x4 (&acc)[2][2][4][2], const pg8::Unit& u, int wr, int wc, int fr, int fq) const {
        const int row0 = u.pm * pg8::BM + wr * 64 + fr, col0 = u.pn * pg8::BM + wc * 32 + 4 * fq;
#pragma unroll
        for (int ai = 0; ai < 2; ++ai)
#pragma unroll
            for (int m = 0; m < 4; ++m) { const int row = row0 + ai * pg8::HALF + m * 16; float ss = 0.f;
#pragma unroll
                for (int bj = 0; bj < 2; ++bj)
#pragma unroll
                    for (int n = 0; n < 2; ++n) { const int col = col0 + bj * pg8::HALF + n * 16; const size_t o = (size_t)row * DM + col;
                        const f32x4 hv = *(const f32x4*)(x + o) + acc[ai][bj][m][n] * (1.f / 256.f);     const f32x4 gv = *(const f32x4*)(g2 + col);
                        v2u w; w.x = pg8::cvt_pk_bf16(hv[0] * gv[0], hv[1] * gv[1]); w.y = pg8::cvt_pk_bf16(hv[2] * gv[2], hv[3] * gv[3]); *(v2u*)(hb + o) = w;
                        ss += (hv[0] * hv[0] + hv[1] * hv[1]) + (hv[2] * hv[2] + hv[3] * hv[3]); }
                ss = xl_swap32(xl_swap16(ss));
                if (fq == 0) rowss[(size_t)row * 16 + u.pn * 4 + wc] = ss; }
    }
};
__device__ __forceinline__ float row_rstd(const float* rowss, int row) { const f32x4* p = (const f32x4*)(rowss + (size_t)row * 16); const f32x4 a = p[0], b = p[1], c = p[2], d = p[3];
    const float s = (((a[0] + a[1]) + (a[2] + a[3])) + ((b[0] + b[1]) + (b[2] + b[3]))) + (((c[0] + c[1]) + (c[2] + c[3])) + ((d[0] + d[1]) + (d[2] + d[3]))); return 1.f / sqrtf(s * (1.f / 1024.f) + EPS); }
struct QpNormEpi {
    static constexpr bool PERM = true, AFTER_DRAIN = false; bf16* qp; const float* rowss;
    __device__ __forceinline__ void operator()(const pg8::f32x4 (&acc)[2][2][4][2], const pg8::Unit& u, int wr, int wc, int fr, int fq) const {
        const int row0 = u.pm * pg8::BM + wr * 64 + fr, col0 = u.pn * pg8::BM + wc * 32 + 8 * fq;
#pragma unroll
        for (int ai = 0; ai < 2; ++ai)
#pragma unroll
            for (int m = 0; m < 4; ++m) { const int row = row0 + ai * pg8::HALF + m * 16; const float rs = row_rstd(rowss, row);
#pragma unroll
                for (int bj = 0; bj < 2; ++bj) { const f32x4 v0 = acc[ai][bj][m][0] * rs, v1 = acc[ai][bj][m][1] * rs;
                    v4u w; w.x = pg8::cvt_pk_bf16(v0[0], v0[1]); w.y = pg8::cvt_pk_bf16(v0[2], v0[3]); w.z = pg8::cvt_pk_bf16(v1[0], v1[1]); w.w = pg8::cvt_pk_bf16(v1[2], v1[3]);
                    *(v4u*)(qp + (size_t)row * 2048 + col0 + bj * pg8::HALF) = w; } }
    }
};

__device__ __forceinline__ void p2_prep(const Args& a, const Ctx& X) {
    unsigned char* ws = a.ws; bf16* proj = (bf16*)(ws + WS_PROJ); const float2* rope = (const float2*)(ws + WS_ROPE);
    bf16* KC = (bf16*)(ws + WS_KCVC); bf16* VC = KC + (size_t)4 * SEQ * 64;
    const int gw = X.bid * NWAVES + X.wave, NGW = X.G * NWAVES, lane = X.lane;
    const float qg = a.in[3][lane], kg1 = a.in[4][64 + lane], kg2 = a.in[4][128 + lane];
    constexpr int NR = 4;
    for (int m0 = gw; m0 < M_TOK; m0 += NR * NGW) {
        float x[NR][12], ss[NR][12]; bf16 kv[NR][4]; float2 cs[NR];
#pragma unroll
        for (int k = 0; k < NR; ++k) { const int m = min(m0 + k * NGW, M_TOK - 1); const bf16* row = proj + (size_t)m * PJ; cs[k] = rope[(m & (SEQ - 1)) * 32 + (lane & 31)];
#pragma unroll
            for (int i = 0; i < 12; ++i) { const int col = (i < 8) ? i * 64 : (i < 10) ? C_KV + 2 * 128 + (i - 8) * 64 : C_KV + 4 * 128 + (i - 10) * 64; x[k][i] = bf2f(row[col + lane]); }
            kv[k][0] = row[C_KV + lane]; kv[k][1] = row[C_KV + 64 + lane]; kv[k][2] = row[C_KV + 128 + lane]; kv[k][3] = row[C_KV + 128 + 64 + lane]; }
#pragma unroll
        for (int k = 0; k < NR; ++k)
#pragma unroll
            for (int i = 0; i < 12; ++i) ss[k][i] = wave_sum(x[k][i] * x[k][i]);
#pragma unroll
        for (int k = 0; k < NR; ++k) { const int m = m0 + k * NGW; if (m >= M_TOK) break; const int t = m & (SEQ - 1), b = m >> 13; bf16* row = proj + (size_t)m * PJ;
#pragma unroll
            for (int i = 0; i < 12; ++i) { const int col = (i < 8) ? i * 64 : (i < 10) ? C_KV + 2 * 128 + (i - 8) * 64 : C_KV + 4 * 128 + (i - 10) * 64;
                const float gain = (i < 8) ? qg : (i < 10) ? kg1 : kg2;
                const float y = x[k][i] * (1.f / sqrtf(ss[k][i] * (1.f / 64.f) + EPS)) * gain; const float pr = xl_xor32(y, lane);
                const float o = (lane < 32) ? y * cs[k].x - pr * cs[k].y : y * cs[k].x + pr * cs[k].y;
                row[col + lane] = (bf16)f2bf((i < 8) ? o * QSCALE : o); }
            { const size_t d0 = ((size_t)(b * 2 + 0) * SEQ + t) * 64 + lane, d1 = ((size_t)(b * 2 + 1) * SEQ + t) * 64 + lane; KC[d0] = kv[k][0]; KC[d1] = kv[k][1]; VC[d0] = kv[k][2]; VC[d1] = kv[k][3]; } }
    }
}

typedef short bf16x8 __attribute__((ext_vector_type(8)));
typedef short s16x4 __attribute__((ext_vector_type(4)));
constexpr int NSA_K0 = 0, NSA_V0 = 32768, NSA_IMP = 65536, NSA_MSK = 98304, NSA_F = 99328, NSA_LDS_END = 99328 + 32768;
__device__ __forceinline__ int swz(int row, int chunk) { return row * 128 + ((chunk ^ ((row >> 1) & 7)) << 4); }
__device__ __forceinline__ s16x4 vtr(const LAS unsigned char* p) { return __builtin_bit_cast(s16x4, __builtin_amdgcn_ds_read_tr16_b64_v4i16((LAS s16x4*)p)); }
__device__ __forceinline__ bf16x8 pack_p(const f32x4& a, const f32x4& b) {
    v4u w; w.x = pg8::cvt_pk_bf16(a[0], a[1]); w.y = pg8::cvt_pk_bf16(a[2], a[3]); w.z = pg8::cvt_pk_bf16(b[0], b[1]); w.w = pg8::cvt_pk_bf16(b[2], b[3]); return __builtin_bit_cast(bf16x8, w); }

struct LaneGeo { int koff0, koff1, voff[4]; };
__device__ __forceinline__ LaneGeo lane_geo(int lane) {
    LaneGeo G; const int r = lane & 15, g4 = lane >> 4;
    G.koff0 = swz(r, g4); G.koff1 = swz(r, 4 + g4);
    const int vr = 4 * g4 + (r >> 2), c0 = (lane & 3) >> 1, hf = lane & 1;
#pragma unroll
    for (int dt = 0; dt < 4; ++dt) G.voff[dt] = swz(vr, 2 * dt + c0) + hf * 8;
    return G;
}
__device__ __forceinline__ void quad_scores(const LAS unsigned char* Kb, const LaneGeo& G, const bf16x8& q0, const bf16x8& q1, float c0, f32x4 (&s)[4]) {
#pragma unroll
    for (int kt = 0; kt < 4; ++kt) {
        const bf16x8 a0 = *(const LAS bf16x8*)(Kb + G.koff0 + kt * 2048), a1 = *(const LAS bf16x8*)(Kb + G.koff1 + kt * 2048);
        s[kt] = __builtin_amdgcn_mfma_f32_16x16x32_bf16(a0, q0, (f32x4){c0, c0, c0, c0}, 0, 0, 0);
        s[kt] = __builtin_amdgcn_mfma_f32_16x16x32_bf16(a1, q1, s[kt], 0, 0, 0);
    }
}
__device__ __forceinline__ void quad_pv(const LAS unsigned char* Vb, const LaneGeo& G, const f32x4 (&p)[4], f32x4 (&o)[4]) {
    const bf16x8 p01 = pack_p(p[0], p[1]), p23 = pack_p(p[2], p[3]);
#pragma unroll
    for (int dt = 0; dt < 4; ++dt) {
        const s16x4 v0 = vtr(Vb + G.voff[dt]), v1 = vtr(Vb + G.voff[dt] + 2048), v2 = vtr(Vb + G.voff[dt] + 4096), v3 = vtr(Vb + G.voff[dt] + 6144);
        const bf16x8 va = (bf16x8){v0[0], v0[1], v0[2], v0[3], v1[0], v1[1], v1[2], v1[3]}, vb = (bf16x8){v2[0], v2[1], v2[2], v2[3], v3[0], v3[1], v3[2], v3[3]};
        o[dt] = __builtin_amdgcn_mfma_f32_16x16x32_bf16(va, p01, o[dt], 0, 0, 0);
        o[dt] = __builtin_amdgcn_mfma_f32_16x16x32_bf16(vb, p23, o[dt], 0, 0, 0);
    }
}
__device__ __forceinline__ void pair_scores(const LAS unsigned char* Kb, const LaneGeo& G, const bf16x8 (&q0)[2], const bf16x8 (&q1)[2], float cA, float cB, f32x4 (&sA)[4], f32x4 (&sB)[4]) {
#pragma unroll
    for (int kt = 0; kt < 4; ++kt) { const bf16x8 a0 = *(const LAS bf16x8*)(Kb + G.koff0 + kt * 2048), a1 = *(const LAS bf16x8*)(Kb + G.koff1 + kt * 2048);
        sA[kt] = __builtin_amdgcn_mfma_f32_16x16x32_bf16(a0, q0[0], (f32x4){cA, cA, cA, cA}, 0, 0, 0);
        sB[kt] = __builtin_amdgcn_mfma_f32_16x16x32_bf16(a0, q0[1], (f32x4){cB, cB, cB, cB}, 0, 0, 0);
        sA[kt] = __builtin_amdgcn_mfma_f32_16x16x32_bf16(a1, q1[0], sA[kt], 0, 0, 0);
        sB[kt] = __builtin_amdgcn_mfma_f32_16x16x32_bf16(a1, q1[1], sB[kt], 0, 0, 0); }
}
__device__ __forceinline__ void pair_pv(const LAS unsigned char* Vb, const LaneGeo& G, const f32x4 (&pA)[4], const f32x4 (&pB)[4], f32x4 (&oA)[4], f32x4 (&oB)[4], f32x4& lA, f32x4& lB) {
    const bf16x8 pA01 = pack_p(pA[0], pA[1]), pA23 = pack_p(pA[2], pA[3]), pB01 = pack_p(pB[0], pB[1]), pB23 = pack_p(pB[2], pB[3]);
    const bf16x8 ones = (bf16x8){0x3F80, 0x3F80, 0x3F80, 0x3F80, 0x3F80, 0x3F80, 0x3F80, 0x3F80};
    lA = __builtin_amdgcn_mfma_f32_16x16x32_bf16(ones, pA01, lA, 0, 0, 0); lB = __builtin_amdgcn_mfma_f32_16x16x32_bf16(ones, pB01, lB, 0, 0, 0);
    lA = __builtin_amdgcn_mfma_f32_16x16x32_bf16(ones, pA23, lA, 0, 0, 0); lB = __builtin_amdgcn_mfma_f32_16x16x32_bf16(ones, pB23, lB, 0, 0, 0);
#pragma unroll
    for (int dt = 0; dt < 4; ++dt) { s16x4 v[4];
#pragma unroll
        for (int kt = 0; kt < 4; ++kt) v[kt] = vtr(Vb + G.voff[dt] + kt * 2048);
        const bf16x8 va = (bf16x8){v[0][0], v[0][1], v[0][2], v[0][3], v[1][0], v[1][1], v[1][2], v[1][3]}, vb = (bf16x8){v[2][0], v[2][1], v[2][2], v[2][3], v[3][0], v[3][1], v[3][2], v[3][3]};
        oA[dt] = __builtin_amdgcn_mfma_f32_16x16x32_bf16(va, pA01, oA[dt], 0, 0, 0);
        oB[dt] = __builtin_amdgcn_mfma_f32_16x16x32_bf16(va, pB01, oB[dt], 0, 0, 0);
        oA[dt] = __builtin_amdgcn_mfma_f32_16x16x32_bf16(vb, pA23, oA[dt], 0, 0, 0);
        oB[dt] = __builtin_amdgcn_mfma_f32_16x16x32_bf16(vb, pB23, oB[dt], 0, 0, 0); }
}
#define LDS_BARRIER() do { asm volatile("s_waitcnt lgkmcnt(0)" ::: "memory"); __builtin_amdgcn_s_barrier(); asm volatile("" ::: "memory"); } while (0)
template <class SrcF, class CompF>
__device__ __forceinline__ void stream_blocks(LAS unsigned char* lds, int nblk, int wave, int lane, SrcF src, CompF comp) {
    const int row = 8 * wave + (lane >> 3), chunk = lane & 7; const int woff = swz(row, chunk);
    __syncthreads();
    if (nblk <= 0) return;
    v4u ka, va, kb, vb; const int last = nblk - 1;
#define SBLK_LD(b_, K_, V_) do { const unsigned char* kp; const unsigned char* vp; int pitch; src(min((b_), last), kp, vp, pitch); K_ = *(const v4u*)(kp + (size_t)row * pitch + chunk * 16); V_ = *(const v4u*)(vp + (size_t)row * pitch + chunk * 16); } while (0)
    SBLK_LD(0, ka, va); SBLK_LD(1, kb, vb);
    for (int b = 0, par = 0; b < nblk; b += 2, par ^= 1) {
        LAS unsigned char* K0 = lds + NSA_K0 + par * 16384; LAS unsigned char* V0 = lds + NSA_V0 + par * 16384;
        *(LAS v4u*)(K0 + woff) = ka; *(LAS v4u*)(V0 + woff) = va; *(LAS v4u*)(K0 + 8192 + woff) = kb; *(LAS v4u*)(V0 + 8192 + woff) = vb;
        LDS_BARRIER();
        SBLK_LD(b + 2, ka, va); SBLK_LD(b + 3, kb, vb);
        comp(b, K0, V0);
        if (b + 1 < nblk) comp(b + 1, K0 + 8192, V0 + 8192);
    }
#undef SBLK_LD
}

__device__ __forceinline__ void nsa_tile(const Args& a, LAS unsigned char* lds, int bg, int qt, int tid, float M2) {
    unsigned char* ws = a.ws; const unsigned char* proj = ws + WS_PROJ;
    const int lane = tid & 63, wave = __builtin_amdgcn_readfirstlane(tid >> 6), g4 = lane >> 4, col = lane & 15, tok = col >> 2, h = col & 3;
    const int b = bg >> 1, g = bg & 1, t0 = qt * 64, cur = qt; const size_t rb = (size_t)b * SEQ;
    const LaneGeo G = lane_geo(lane);
    LAS float* imp = (LAS float*)(lds + NSA_IMP); LAS unsigned* msk = (LAS unsigned*)(lds + NSA_MSK);
    for (int i = tid; i < 64 * 128; i += 512) imp[i] = 0.f;
    bf16x8 q0[2], q1[2]; int tl[2]; LAS bf16* Fl = (LAS bf16*)(lds + NSA_F) + tid;
#pragma unroll
    for (int qd = 0; qd < 2; ++qd) { tl[qd] = 8 * wave + 4 * qd + tok;
        const bf16* qp = (const bf16*)proj + (rb + t0 + tl[qd]) * PJ + (g * 4 + h) * 64 + 8 * g4;
        q0[qd] = *(const bf16x8*)qp; q1[qd] = *(const bf16x8*)(qp + 32); }
    const float* gnp = (const float*)(ws + WS_GN);
    const int nc_max = min(511, (t0 >> 4) + 3), nch = (nc_max + 63) >> 6;
    const unsigned char* kc16 = ws + WS_KC16 + (size_t)bg * 512 * 128; const unsigned char* vc16 = ws + WS_VC16 + (size_t)bg * 512 * 128;
    int ncol[2]; float linv[2];
#pragma unroll
    for (int qd = 0; qd < 2; ++qd) { const int t = t0 + tl[qd]; ncol[qd] = t >= 31 ? ((t - 31) >> 4) + 1 : 0; linv[qd] = 0.f; }
    auto src_c = [&](int bi, const unsigned char*& kp, const unsigned char*& vp, int& pitch) __attribute__((always_inline)) { kp = kc16 + (size_t)bi * 64 * 128; vp = vc16 + (size_t)bi * 64 * 128; pitch = 128; };
    stream_blocks(lds, nch, wave, lane, src_c, [&](int bi, const LAS unsigned char* Kb, const LAS unsigned char* Vb) __attribute__((always_inline)) {
#pragma unroll
        for (int qd = 0; qd < 2; ++qd) { f32x4 s[4]; quad_scores(Kb, G, q0[qd], q1[qd], -M2, s);
#pragma unroll
            for (int kt = 0; kt < 4; ++kt)
#pragma unroll
                for (int r = 0; r < 4; ++r) { const int c = bi * 64 + 16 * kt + 4 * g4 + r; linv[qd] += (c < ncol[qd]) ? __builtin_amdgcn_exp2f(s[kt][r]) : 0.f; } }
    });
#pragma unroll
    for (int qd = 0; qd < 2; ++qd) { float l = linv[qd]; l = xl_swap32(xl_swap16(l)); linv[qd] = l > 0.f ? 1.f / l : 0.f; }
    {
        f32x4 O[2][4];
#pragma unroll
        for (int qd = 0; qd < 2; ++qd)
#pragma unroll
            for (int dt = 0; dt < 4; ++dt) O[qd][dt] = (f32x4){0.f, 0.f, 0.f, 0.f};
        stream_blocks(lds, nch, wave, lane, src_c, [&](int bi, const LAS unsigned char* Kb, const LAS unsigned char* Vb) __attribute__((always_inline)) {
    #pragma unroll
            for (int qd = 0; qd < 2; ++qd) { f32x4 s[4]; quad_scores(Kb, G, q0[qd], q1[qd], -M2, s);
#pragma unroll
                for (int kt = 0; kt < 4; ++kt) {
#pragma unroll
                    for (int r = 0; r < 4; ++r) { const int c = bi * 64 + 16 * kt + 4 * g4 + r; s[kt][r] = (c < ncol[qd]) ? __builtin_amdgcn_exp2f(s[kt][r]) * linv[qd] : 0.f; }
                    float A = s[kt][0] + s[kt][1] + s[kt][2] + 0.5f * s[kt][3], B = 0.5f * s[kt][3];
                    A = quad_sum(A); B = quad_sum(B);
                    const int Gi = bi * 16 + 4 * kt + g4;
                    if (h == 0) { atomicAdd((float*)(imp + tl[qd] * 128 + Gi), A); if (Gi + 1 < 128) atomicAdd((float*)(imp + tl[qd] * 128 + Gi + 1), B); }
                }
                quad_pv(Vb, G, s, O[qd]); }
        });
#pragma unroll
        for (int qd = 0; qd < 2; ++qd) { const float g0 = gnp[(rb + t0 + tl[qd]) * 24 + g * 4 + h];
#pragma unroll
            for (int dt = 0; dt < 4; ++dt)
#pragma unroll
                for (int r = 0; r < 4; ++r) Fl[((qd * 4 + dt) * 4 + r) * 512] = (bf16)f2bf(O[qd][dt][r] * g0); }
    }
    __syncthreads();
#pragma nounroll
    for (int ps = 0; ps < 2; ++ps) { const int tlw = 8 * wave + 4 * (ps & 1) + g4, sub = lane & 15; unsigned m0 = 0u, m1 = 0u, m2 = 0u, m3 = 0u;
        if (cur <= 15) { m0 = (1u << (cur + 1)) - 1u; }
        else { float x[8];
#pragma unroll
            for (int i = 0; i < 8; ++i) { const int j = sub + 16 * i; x[i] = (j >= 1 && j <= cur - 2) ? __uint_as_float((__float_as_uint(imp[tlw * 128 + j]) & ~127u) | (unsigned)(127 - j)) : -3.0e38f; }
#pragma nounroll
            for (int k = 0; k < 13; ++k) { float m = fmaxf(fmaxf(fmaxf(x[0], x[1]), fmaxf(x[2], x[3])), fmaxf(fmaxf(x[4], x[5]), fmaxf(x[6], x[7])));
                m = row_max(m);
                const int bi = 127 - (int)(__float_as_uint(m) & 127u);
                const unsigned bit = 1u << (bi & 31); const int wsel = bi >> 5; m0 |= (wsel == 0) ? bit : 0u; m1 |= (wsel == 1) ? bit : 0u; m2 |= (wsel == 2) ? bit : 0u; m3 |= (wsel == 3) ? bit : 0u;
#pragma unroll
                for (int i = 0; i < 8; ++i) x[i] = (x[i] == m) ? -3.0e38f : x[i]; }
            m0 |= 1u;
#pragma unroll
            for (int f = 0; f < 2; ++f) { const int bi = cur - f; const unsigned bit = 1u << (bi & 31); const int wsel = bi >> 5; m0 |= (wsel == 0) ? bit : 0u; m1 |= (wsel == 1) ? bit : 0u; m2 |= (wsel == 2) ? bit : 0u; m3 |= (wsel == 3) ? bit : 0u; } }
        if (sub == 0) { msk[tlw * 4 + 0] = m0; msk[tlw * 4 + 1] = m1; msk[tlw * 4 + 2] = m2; msk[tlw * 4 + 3] = m3;
        } }
    __syncthreads();
    LAS unsigned char* qpark = lds + NSA_IMP + tid * 16;
    *(LAS bf16x8*)(qpark) = q0[0]; *(LAS bf16x8*)(qpark + 8192) = q1[0]; *(LAS bf16x8*)(qpark + 16384) = q0[1]; *(LAS bf16x8*)(qpark + 24576) = q1[1];
    {
        f32x4 O[2][4]; f32x4 lacc[2];
#pragma unroll
        for (int qd = 0; qd < 2; ++qd) { lacc[qd] = (f32x4){0.f, 0.f, 0.f, 0.f};
#pragma unroll
            for (int dt = 0; dt < 4; ++dt) O[qd][dt] = (f32x4){0.f, 0.f, 0.f, 0.f}; }
        const unsigned char* ksb = proj + (rb * PJ + C_KV + 2 * 128 + g * 64) * 2; const unsigned char* vsb = proj + (rb * PJ + C_KV + 3 * 128 + g * 64) * 2;
        stream_blocks(lds, cur + 1, wave, lane,
            [&](int j, const unsigned char*& kp, const unsigned char*& vp, int& pitch) __attribute__((always_inline)) { kp = ksb + (size_t)j * 64 * PJ * 2; vp = vsb + (size_t)j * 64 * PJ * 2; pitch = PJ * 2; },
            [&](int j, const LAS unsigned char* Kb, const LAS unsigned char* Vb) __attribute__((always_inline)) {
                const bool selA = (msk[tl[0] * 4 + (j >> 5)] >> (j & 31)) & 1u, selB = (msk[tl[1] * 4 + (j >> 5)] >> (j & 31)) & 1u;
                if (__ballot(selA || selB) != 0ull) { f32x4 sA[4], sB[4];
                    const bf16x8 qa[2] = {*(const LAS bf16x8*)(qpark), *(const LAS bf16x8*)(qpark + 16384)}, qb[2] = {*(const LAS bf16x8*)(qpark + 8192), *(const LAS bf16x8*)(qpark + 24576)};
                    pair_scores(Kb, G, qa, qb, selA ? -M2 : -1.0e30f, selB ? -M2 : -1.0e30f, sA, sB);
                    if (j < cur) {
#pragma unroll
                        for (int kt = 0; kt < 4; ++kt)
#pragma unroll
                            for (int r = 0; r < 4; ++r) { const float eA = __builtin_amdgcn_exp2f(sA[kt][r]), eB = __builtin_amdgcn_exp2f(sB[kt][r]); sA[kt][r] = eA; sB[kt][r] = eB; }
                    } else {
#pragma unroll
                        for (int kt = 0; kt < 4; ++kt)
#pragma unroll
                            for (int r = 0; r < 4; ++r) { const int key = 16 * kt + 4 * g4 + r; const float eA = (key <= tl[0]) ? __builtin_amdgcn_exp2f(sA[kt][r]) : 0.f, eB = (key <= tl[1]) ? __builtin_amdgcn_exp2f(sB[kt][r]) : 0.f;
                                sA[kt][r] = eA; sB[kt][r] = eB; }
                    }
                    pair_pv(Vb, G, sA, sB, O[0], O[1], lacc[0], lacc[1]); }
            });
#pragma unroll
        for (int qd = 0; qd < 2; ++qd) { const float ls = lacc[qd][0]; const float sc = gnp[(rb + t0 + tl[qd]) * 24 + 8 + g * 4 + h] / ls;
#pragma unroll
            for (int dt = 0; dt < 4; ++dt)
#pragma unroll
                for (int r = 0; r < 4; ++r) Fl[((qd * 4 + dt) * 4 + r) * 512] = (bf16)f2bf(bf2f(Fl[((qd * 4 + dt) * 4 + r) * 512]) + O[qd][dt][r] * sc); }
    }
    {
        f32x4 O[2][4]; f32x4 lacc[2];
#pragma unroll
        for (int qd = 0; qd < 2; ++qd) { lacc[qd] = (f32x4){0.f, 0.f, 0.f, 0.f};
#pragma unroll
            for (int dt = 0; dt < 4; ++dt) O[qd][dt] = (f32x4){0.f, 0.f, 0.f, 0.f}; }
        const int i0 = (cur >= 8) ? 0 : 8 - cur;
        const unsigned char* kwb = proj + (rb * PJ + C_KV + 4 * 128 + g * 64) * 2; const unsigned char* vwb = proj + (rb * PJ + C_KV + 5 * 128 + g * 64) * 2;
        stream_blocks(lds, 9 - i0, wave, lane,
            [&](int bi, const unsigned char*& kp, const unsigned char*& vp, int& pitch) __attribute__((always_inline)) { const int p0 = t0 - 512 + 64 * (bi + i0); kp = kwb + (size_t)p0 * PJ * 2; vp = vwb + (size_t)p0 * PJ * 2; pitch = PJ * 2; },
            [&](int bi, const LAS unsigned char* Kb, const LAS unsigned char* Vb) __attribute__((always_inline)) { const int i = bi + i0;
                f32x4 sA[4], sB[4];
                const bf16x8 qa[2] = {*(const LAS bf16x8*)(qpark), *(const LAS bf16x8*)(qpark + 16384)}, qb[2] = {*(const LAS bf16x8*)(qpark + 8192), *(const LAS bf16x8*)(qpark + 24576)};
                pair_scores(Kb, G, qa, qb, -M2, -M2, sA, sB);
                if (i != 0 && i != 8) {
#pragma unroll
                    for (int kt = 0; kt < 4; ++kt)
#pragma unroll
                        for (int r = 0; r < 4; ++r) { const float eA = __builtin_amdgcn_exp2f(sA[kt][r]), eB = __builtin_amdgcn_exp2f(sB[kt][r]); sA[kt][r] = eA; sB[kt][r] = eB; }
                } else {
#pragma unroll
                    for (int kt = 0; kt < 4; ++kt)
#pragma unroll
                        for (int r = 0; r < 4; ++r) { const int key = 16 * kt + 4 * g4 + r; const bool okA = (i == 0) ? (key > tl[0]) : (key <= tl[0]), okB = (i == 0) ? (key > tl[1]) : (key <= tl[1]);
                            const float eA = okA ? __builtin_amdgcn_exp2f(sA[kt][r]) : 0.f, eB = okB ? __builtin_amdgcn_exp2f(sB[kt][r]) : 0.f; sA[kt][r] = eA; sB[kt][r] = eB; }
                }
                pair_pv(Vb, G, sA, sB, O[0], O[1], lacc[0], lacc[1]);
            });
        bf16* onsa = (bf16*)(ws + WS_ONSA);
#pragma unroll
        for (int qd = 0; qd < 2; ++qd) { const float ls = lacc[qd][0]; const float sc = gnp[(rb + t0 + tl[qd]) * 24 + 16 + g * 4 + h] / ls;
#pragma unroll
            for (int dt = 0; dt < 4; ++dt) { float f[4];
#pragma unroll
                for (int r = 0; r < 4; ++r) f[r] = bf2f(Fl[((qd * 4 + dt) * 4 + r) * 512]) + O[qd][dt][r] * sc;
                *(unsigned*)((unsigned char*)onsa + (size_t)(rb + t0 + tl[qd]) * 512 + (g * 4 + h) * 64 + 4 * g4 + 16 * dt) = pack4_fp8(16.f * f[0], 16.f * f[1], 16.f * f[2], 16.f * f[3]); } }
    }
    __syncthreads();
}

__device__ __forceinline__ float exp_fast(float x) { return __builtin_amdgcn_exp2f(x * 1.4426950408889634f); }
__device__ __forceinline__ float softplus_fast(float z) { return fmaxf(z, 0.f) + 0.6931471805599453f * __builtin_amdgcn_logf(1.f + __builtin_amdgcn_exp2f(-fabsf(z) * 1.4426950408889634f)); }
__device__ __forceinline__ void sb_tile(const Args& a, LAS unsigned char* lds, int bh, int tile, int tid) {
    unsigned char* ws = a.ws; const unsigned char* proj = ws + WS_PROJ;
    const int lane = tid & 63, wave = __builtin_amdgcn_readfirstlane(tid >> 6), g4 = lane >> 4, col = lane & 15;
    const int b = bh >> 3, hh = bh & 7, t0 = tile * 128, tw0 = t0 + 16 * wave, t = tw0 + col; const size_t rb = (size_t)b * SEQ;
    const LaneGeo G = lane_geo(lane);
    const bf16* qp = (const bf16*)proj + (rb + t) * PJ + C_SB + hh * 64 + 8 * g4;
    const bf16x8 q0 = *(const bf16x8*)qp, q1 = *(const bf16x8*)(qp + 32);
    f32x4 o[4];
#pragma unroll
    for (int dt = 0; dt < 4; ++dt) o[dt] = (f32x4){0.f, 0.f, 0.f, 0.f};
    float carry = 0.f;
    const unsigned char* kbase = proj + (rb * PJ + C_SB + 512 + hh * 64) * 2; const unsigned char* vbase = proj + (rb * PJ + C_SB + 1024 + hh * 64) * 2;
    const int row = 8 * wave + (lane >> 3), chunk = lane & 7; const int woff = swz(row, chunk);
    int kb = (t0 >> 6) + 1;
    __syncthreads();
    v4u kr0, vr0, kr1, vr1;
#define SBT_LD(kb_, K_, V_) do { const size_t off = ((size_t)(kb_) * 64 + row) * (PJ * 2) + chunk * 16; K_ = *(const v4u*)(kbase + off); V_ = *(const v4u*)(vbase + off); } while (0)
#define SBT_STEP(par_, K_, V_) { LAS unsigned char* Kb = lds + NSA_K0 + (par_) * 8192; LAS unsigned char* Vb = lds + NSA_V0 + (par_) * 8192; \
        *(LAS v4u*)(Kb + woff) = K_; *(LAS v4u*)(Vb + woff) = V_; \
        __syncthreads(); \
        if (kb > 1) SBT_LD(kb - 2, K_, V_); \
        bool pending = true; \
        if (64 * kb <= tw0 + 14) { \
            f32x4 s[4]; quad_scores(Kb, G, q0, q1, 0.f, s); \
            _Pragma("unroll") for (int kt = 3; kt >= 0; --kt) { \
                float sp[4], z[4]; \
                _Pragma("unroll") for (int r = 0; r < 4; ++r) { const int key = 64 * kb + 16 * kt + 4 * g4 + r; z[r] = s[kt][r] * 0.125f; sp[r] = (key < t) ? softplus_fast(z[r]) : 0.f; } \
                const float g = (sp[0] + sp[1]) + (sp[2] + sp[3]); \
                  \
                const auto r16_ = __builtin_amdgcn_permlane16_swap(__float_as_uint(g), __float_as_uint(g), false, false); const float s16 = __uint_as_float(r16_[0]) + __uint_as_float(r16_[1]); \
                const auto r32_ = __builtin_amdgcn_permlane32_swap(__float_as_uint(s16), __float_as_uint(s16), false, false); const float tot = __uint_as_float(r32_[0]) + __uint_as_float(r32_[1]); \
                const float above = (g4 == 0) ? (tot - g) : (g4 == 1) ? (tot - s16) : (g4 == 2) ? (s16 - g) : 0.f; \
                const float c3 = carry + above + sp[3], c2 = c3 + sp[2], c1 = c2 + sp[1], c0 = c1 + sp[0]; \
                const int key0 = 64 * kb + 16 * kt + 4 * g4; \
                s[kt][3] = (key0 + 3 < t) ? exp_fast(z[3] - c3) : 0.f; s[kt][2] = (key0 + 2 < t) ? exp_fast(z[2] - c2) : 0.f; \
                s[kt][1] = (key0 + 1 < t) ? exp_fast(z[1] - c1) : 0.f; s[kt][0] = (key0 < t) ? exp_fast(z[0] - c0) : 0.f; \
                carry += tot; } \
            quad_pv(Vb, G, s, o); \
            pending = !__all(carry > 80.f); } \
        if (kb == 0) break; \
        --kb; \
        if (!__syncthreads_or(pending ? 1 : 0)) break; }
    SBT_LD(kb, kr0, vr0); if (kb > 0) SBT_LD(kb - 1, kr1, vr1);
    for (;;) {
        SBT_STEP(0, kr0, vr0)
        SBT_STEP(1, kr1, vr1)
    }
#undef SBT_LD
#undef SBT_STEP
#pragma unroll
    for (int dt = 0; dt < 4; ++dt) *(unsigned*)(ws + WS_ONSA + (size_t)M_TOK * 512 + (size_t)(rb + t) * 512 + hh * 64 + 4 * g4 + 16 * dt) = pack4_fp8(16.f * o[dt][0], 16.f * o[dt][1], 16.f * o[dt][2], 16.f * o[dt][3]);
    __syncthreads();
}

typedef long i64_t;
constexpr int PE_EX = 0, PE_GW = 8192, PE_AW = 16384, PE_WAVE = 24576, PE_WAVE_BYTES = 3072, PE_SK = 49152, PE_SK_ROW = 272, PE_HF = 118784, PE_HZ = 135168;
__device__ const unsigned char PAIR_TAB[52] = {
    0x00,0x01,0x02,0x03,0x04,0x05,0x06,0x07,0x08,0x09,0x0a,0x0b,0x0c,0x0d,0x0e,0x0f,
    0x10,0x11,0x12,0x13,0x14,0x15,0x16,0x17,
    0x20,0x21,0x22,0x23,0x24,
    0x30,0x31,0x32,0x33,
    0x40,0x41,0x42,
    0x50,0x51,
    0x60,0x61,
    0x70,0x71,
    0x80,0x90,0xa0,0xb0,0xc0,0xd0,0xe0,0xf0,
    0xff,0xff};
typedef float f32x2v __attribute__((ext_vector_type(2)));
__device__ __forceinline__ unsigned pack4_i8(float x0, float x1, float x2, float x3) { return ((unsigned)(__float2int_rn(x0) & 255)) | ((unsigned)(__float2int_rn(x1) & 255) << 8) | ((unsigned)(__float2int_rn(x2) & 255) << 16) | ((unsigned)(__float2int_rn(x3) & 255) << 24); }
template <int NR, int MODE> __device__ __forceinline__ void quant_rows(const float* s0, size_t sstride, unsigned char* d0, size_t dstride, float* sc0, int scstride, int lane) {
    f32x4 x[NR][4]; float am[NR];
#pragma unroll
    for (int k = 0; k < NR; ++k) { const f32x4* s4 = (const f32x4*)(s0 + (size_t)k * sstride) + lane; am[k] = 0.f;
#pragma unroll
        for (int j = 0; j < 4; ++j) x[k][j] = s4[64 * j]; }
#pragma unroll
    for (int k = 0; k < NR; ++k)
#pragma unroll
        for (int j = 0; j < 4; ++j) am[k] = fmaxf(am[k], fmaxf(fmaxf(fabsf(x[k][j][0]), fabsf(x[k][j][1])), fmaxf(fabsf(x[k][j][2]), fabsf(x[k][j][3]))));
#pragma unroll
    for (int k = 0; k < NR; ++k) am[k] = wave_max(am[k]);
#pragma unroll
    for (int k = 0; k < NR; ++k) { const float sc = am[k] > 0.f ? am[k] * (MODE ? (1.f / 127.f) : (1.f / 440.f)) : 1.f; const float inv = 1.f / sc; unsigned* d4 = (unsigned*)(d0 + (size_t)k * dstride) + lane;
#pragma unroll
        for (int j = 0; j < 4; ++j) d4[64 * j] = MODE ? pack4_i8(x[k][j][0] * inv, x[k][j][1] * inv, x[k][j][2] * inv, x[k][j][3] * inv) : pack4_fp8(x[k][j][0] * inv, x[k][j][1] * inv, x[k][j][2] * inv, x[k][j][3] * inv);
        if (lane == 0) sc0[(size_t)k * scstride] = sc; }
}
__device__ __forceinline__ void ce_desc(float& a, float& b) { const float hi = fmaxf(a, b), lo = fminf(a, b); a = hi; b = lo; }
template <int N> __device__ __forceinline__ void bitonic_sort_desc(float (&x)[N]) {
#pragma unroll
    for (int k = 2; k <= N; k <<= 1)
#pragma unroll
        for (int j = k >> 1; j > 0; j >>= 1)
#pragma unroll
            for (int i = 0; i < N; ++i) { const int l = i ^ j; if (l > i) { if ((i & k) == 0) ce_desc(x[i], x[l]); else ce_desc(x[l], x[i]); } }
}
__device__ __forceinline__ void merge_top16(float (&x)[16], int mask) {
    float r[16];
#pragma unroll
    for (int i = 0; i < 16; ++i) r[i] = __shfl_xor(x[15 - i], mask);
#pragma unroll
    for (int i = 0; i < 16; ++i) x[i] = fmaxf(x[i], r[i]);
#pragma unroll
    for (int j = 8; j > 0; j >>= 1)
#pragma unroll
        for (int i = 0; i < 16; ++i) { const int l = i ^ j; if (l > i) ce_desc(x[i], x[l]); }
}

__device__ __forceinline__ void quant_step(const Args& a, int gw, int NGW, int s, int lane) {
    unsigned char* ws = a.ws; const int r = gw + 4 * (s & 1) * NGW;
    if (r + 3 * NGW >= 16384) return;
    if (s < 2) quant_rows<4, 1>(a.in[17] + (size_t)r * DM, (size_t)NGW * DM, ws + WS_U8 + (size_t)r * 1024, (size_t)NGW * 1024, (float*)(ws + WS_SU) + r, NGW, lane);
    else quant_rows<4, 0>(a.in[18] + (size_t)r * DM, (size_t)NGW * DM, ws + WS_V8 + (size_t)r * 1024, (size_t)NGW * 1024, (float*)(ws + WS_SVS) + r, NGW, lane);
}
__device__ __forceinline__ void p5_mixers(const Args& a, const Ctx& X) {
    float* sm = (float*)((unsigned char*)X.lds);
    float M2;
    { const float gq = wave_max(fabsf(a.in[3][X.lane])); const float gk = wave_max(fmaxf(fmaxf(fabsf(a.in[4][X.lane]), fabsf(a.in[4][64 + X.lane])), fabsf(a.in[4][128 + X.lane])));
      M2 = 8.2f * gq * gk * 1.4426950408889634f; }
    const int gwq = X.bid * NWAVES + X.wave, NGWq = X.G * NWAVES; int qs = 0;
    for (int it = X.bid; it < 512; it += X.G) { const int r = it >> 8, idx = it & 255, bg = idx >> 6, qh = idx & 63;
        if (qs < 4) quant_step(a, gwq, NGWq, qs++, X.lane);
        nsa_tile(a, X.lds, bg, r == 0 ? 127 - qh : qh, X.tid, M2);
        if (qs < 4) quant_step(a, gwq, NGWq, qs++, X.lane); }
    if (8 * NGWq != 16384) {
        for (int r = gwq; r < 16384; r += NGWq) quant_rows<1, 1>(a.in[17] + (size_t)r * DM, 0, a.ws + WS_U8 + (size_t)r * 1024, 0, (float*)(a.ws + WS_SU) + r, 0, X.lane);
        for (int r = gwq; r < 16384; r += NGWq) quant_rows<1, 0>(a.in[18] + (size_t)r * DM, 0, a.ws + WS_V8 + (size_t)r * 1024, 0, (float*)(a.ws + WS_SVS) + r, 0, X.lane); }
    else while (qs < 4) quant_step(a, gwq, NGWq, qs++, X.lane);
}
__device__ __forceinline__ void p3_sb(const Args& a, const Ctx& X, int first, int stride) {
    for (int it = first; it < 1024; it += stride) { const int r = it >> 8, idx = it & 255, bh = idx >> 4, th = idx & 15; sb_tile(a, X.lds, bh, r * 16 + th, X.tid); }
}

__device__ __forceinline__ void peer_route16(const Args& a, LAS unsigned char* lds, int m0, int hd, int lane) {
    unsigned char* ws = a.ws; const int col = lane & 15, g4 = lane >> 4;
    LAS float* svL = (LAS float*)(lds + PE_WAVE + hd * PE_WAVE_BYTES); LAS float* cvL = svL + 512;
    const bf16* qp = (const bf16*)(ws + WS_QP) + (size_t)(m0 + col) * 2048 + hd * 256 + 8 * g4; const LAS unsigned char* skL = lds + PE_SK + col * PE_SK_ROW + 16 * g4;
#pragma unroll
    for (int p = 0; p < 2; ++p) {
        f32x4 acc[8];
#pragma unroll
        for (int kt = 0; kt < 8; ++kt) acc[kt] = (f32x4){0.f, 0.f, 0.f, 0.f};
#pragma unroll
        for (int ks = 0; ks < 4; ++ks) { const bf16x8 bq = *(const bf16x8*)(qp + p * 128 + 32 * ks);
#pragma unroll
            for (int kt = 0; kt < 8; ++kt) { const bf16x8 ak = *(const LAS bf16x8*)(skL + (p * 128 + 16 * kt) * PE_SK_ROW + 64 * ks);
                acc[kt] = __builtin_amdgcn_mfma_f32_16x16x32_bf16(ak, bq, acc[kt], 0, 0, 0); } }
        float x[32];
#pragma unroll
        for (int kt = 0; kt < 8; ++kt)
#pragma unroll
            for (int r = 0; r < 4; ++r) { const float av = acc[kt][r]; x[kt * 4 + r] = __uint_as_float((__float_as_uint(av) & ~127u) | (unsigned)(16 * kt + 4 * g4 + r)); }
        bitonic_sort_desc<32>(x);
        float t16[16];
#pragma unroll
        for (int i = 0; i < 16; ++i) t16[i] = x[i];
        merge_top16(t16, 16); merge_top16(t16, 32);
        if (g4 == 0) { LAS f32x4* dstv = (LAS f32x4*)(svL + (p * 16 + col) * 16);
#pragma unroll
            for (int i = 0; i < 4; ++i) dstv[i] = (f32x4){t16[4 * i], t16[4 * i + 1], t16[4 * i + 2], t16[4 * i + 3]}; }
    }
    __builtin_amdgcn_fence(__ATOMIC_RELEASE, "wavefront"); __builtin_amdgcn_wave_barrier(); __builtin_amdgcn_fence(__ATOMIC_ACQUIRE, "wavefront");
    float c[16];
#pragma unroll
    for (int i = 0; i < 16; ++i) { const int ci = g4 + 4 * i; const unsigned ab = PAIR_TAB[min(ci, 51)];
        const float s0 = __uint_as_float(__float_as_uint(svL[(0 * 16 + col) * 16 + (ab >> 4 & 15)]) & ~127u), s1 = __uint_as_float(__float_as_uint(svL[(1 * 16 + col) * 16 + (ab & 15)]) & ~127u);
        c[i] = (ci < 50) ? __uint_as_float((__float_as_uint(s0 + s1) & ~63u) | (unsigned)(63 - ci)) : -3.0e38f; }
    bitonic_sort_desc<16>(c); merge_top16(c, 16); merge_top16(c, 32);
    if (g4 == 0) { LAS f32x4* dstv = (LAS f32x4*)(cvL + col * 16);
#pragma unroll
        for (int i = 0; i < 4; ++i) dstv[i] = (f32x4){c[4 * i], c[4 * i + 1], c[4 * i + 2], c[4 * i + 3]}; }
    __builtin_amdgcn_fence(__ATOMIC_RELEASE, "wavefront"); __builtin_amdgcn_wave_barrier(); __builtin_amdgcn_fence(__ATOMIC_ACQUIRE, "wavefront");
    const float mx = __builtin_bit_cast(float, __builtin_bit_cast(unsigned, cvL[col * 16]) & ~63u);
    float ev[4]; int ee[4]; float ssum = 0.f;
#pragma unroll
    for (int i = 0; i < 4; ++i) { const unsigned cb = __builtin_bit_cast(unsigned, cvL[col * 16 + 4 * g4 + i]); const int ci = 63 - (int)(cb & 63u); const unsigned ab = PAIR_TAB[ci];
        const int i1 = (int)(__builtin_bit_cast(unsigned, svL[(0 * 16 + col) * 16 + (ab >> 4 & 15)]) & 127u), i2 = (int)(__builtin_bit_cast(unsigned, svL[(1 * 16 + col) * 16 + (ab & 15)]) & 127u);
        ee[i] = i1 * 128 + i2; ev[i] = expf(__builtin_bit_cast(float, cb & ~63u) - mx); ssum += ev[i]; }
    ssum = xl_swap32(xl_swap16(ssum)); const float inv = 1.f / ssum;
    LAS int* exL = (LAS int*)(lds + PE_EX); LAS float* gwL = (LAS float*)(lds + PE_GW);
#pragma unroll
    for (int i = 0; i < 4; ++i) { exL[col * 128 + hd * 16 + 4 * g4 + i] = ee[i]; gwL[col * 128 + hd * 16 + 4 * g4 + i] = ev[i] * inv; }
}

__device__ __forceinline__ void peer_emit1(const Args& a, LAS unsigned char* lds, int m, int tk, int lane) {
    unsigned char* ws = a.ws; const int col = lane & 15, g4 = lane >> 4;
    const LAS int* exL = (const LAS int*)(lds + PE_EX) + tk * 128; const LAS float* gwL = (const LAS float*)(lds + PE_GW) + tk * 128;
    {
      const v4u* hr = (const v4u*)((const bf16*)(ws + WS_HN) + (size_t)m * DM + 16 * lane); const v4u w0 = hr[0], w1 = hr[1];
      float f[16] = {bflo(w0.x), bfhi(w0.x), bflo(w0.y), bfhi(w0.y), bflo(w0.z), bfhi(w0.z), bflo(w0.w), bfhi(w0.w), bflo(w1.x), bfhi(w1.x), bflo(w1.y), bfhi(w1.y), bflo(w1.z), bfhi(w1.z), bflo(w1.w), bfhi(w1.w)};
      const float rs_ = row_rstd((const float*)(ws + WS_ROWSS), m);
      float am = 0.f;
#pragma unroll
      for (int i = 0; i < 16; ++i) { f[i] *= rs_; am = fmaxf(am, fabsf(f[i])); }
      am = wave_max(am); const float sh = am > 0.f ? am * (1.f / 127.f) : 1.f; const float inv = 1.f / sh;
      v4u qh; qh.x = pack4_i8(f[0] * inv, f[1] * inv, f[2] * inv, f[3] * inv); qh.y = pack4_i8(f[4] * inv, f[5] * inv, f[6] * inv, f[7] * inv); qh.z = pack4_i8(f[8] * inv, f[9] * inv, f[10] * inv, f[11] * inv); qh.w = pack4_i8(f[12] * inv, f[13] * inv, f[14] * inv, f[15] * inv);
      *(v4u*)(ws + WS_HF8 + (size_t)m * 1024 + 16 * lane) = qh;
      if (lane == 0) ((float*)(ws + WS_SH))[m] = sh; }
    const int e0 = exL[lane], e1 = exL[lane + 64]; const int hh0 = ((e0 >> 7) + e0) & 15, hh1 = ((e1 >> 7) + e1) & 15; const int r0 = ((hh0 & 7) << 1) | (hh0 >> 3), r1 = ((hh1 & 7) << 1) | (hh1 >> 3);       const unsigned long long lt = (1ull << lane) - 1ull;
    int base = 0, pos0 = 0, pos1 = 0, myoff = 0;
#pragma unroll
    for (int rr = 0; rr < 16; ++rr) { const unsigned long long b0 = __ballot(r0 == rr), b1 = __ballot(r1 == rr); const int c0 = __popcll(b0), c1 = __popcll(b1);
        if (r0 == rr) pos0 = base + __popcll(b0 & lt); if (r1 == rr) pos1 = base + c0 + __popcll(b1 & lt);
        if (lane == rr) myoff = base; base += c0 + c1; }
    if (lane == 16) myoff = 128;
    { const int myn = __shfl_down(myoff, 2) - myoff;
      if (lane < 16 && !(lane & 1) && myn > 8 * HU_MAX) { const unsigned slot = __hip_atomic_fetch_add((gu32*)(ws + WS_CTL) + CW_NEXC, 1u, RLX_AGENT); if (slot < (unsigned)EXC_CAP) __hip_atomic_store((gu32*)(ws + WS_CTL) + CW_EXC + slot, ((unsigned)m << 4) | (unsigned)(lane >> 1), RLX_AGENT); } }
    unsigned* plr = (unsigned*)(ws + WS_PLR) + (size_t)m * 128;
    plr[pos0] = ((unsigned)e0 << 16) | f2bf(gwL[lane]); plr[pos1] = ((unsigned)e1 << 16) | f2bf(gwL[lane + 64]);
    if (lane < 32) (ws + WS_OFF)[(size_t)m * 32 + lane] = (unsigned char)myoff;
}
struct PhSet { v4u W[8]; v4u h0; float su, sv, sh; unsigned pw, pwn; };
__device__ __forceinline__ void peer_u_pass2(const Args& a, LAS unsigned char* lds, int wave, int first, int stride, int R, int rr0, int gbase, int lane) {
    unsigned char* ws = a.ws; const unsigned char* U8 = ws + WS_U8; const float* SU = (const float*)(ws + WS_SU); const float* SV = (const float*)(ws + WS_SVS); const unsigned* PLR = (const unsigned*)(ws + WS_PLR);
    unsigned* dump = (unsigned*)(ws + WS_CTL + 65536) + (size_t)(blockIdx.x * NWAVES + wave) * 64 + lane;
    if (first >= M_TOK) return;
    const int nunits = ((M_TOK - 1 - first) / stride + 1) * R;
    LAS unsigned* L = (LAS unsigned*)(lds + wave * 4096);
    int cnt = 0;
    for (int u0 = 0; u0 < nunits; u0 += 64) { const int u = u0 + lane; const bool ok = u < nunits; const int uc = ok ? u : 0;
        const int m = first + (uc / R) * stride, rr = rr0 + 8 * (uc % R); const unsigned char* offp = ws + WS_OFF + (size_t)m * 32; const int off = offp[rr], n = (int)offp[rr + 2] - off;
        const int nh = ok ? min(max((n - gbase + 7) >> 3, 1), HU_MAX) : 0;
        int pre = nh;
#pragma unroll
        for (int o = 1; o < 64; o <<= 1) { const int y = __shfl_up(pre, o); if (lane >= o) pre += y; }
        const int pos = cnt + pre - nh;
#pragma unroll
        for (int i = 0; i < 4; ++i) if (i < nh && pos + i < 510) { L[2 * (pos + i)] = (unsigned)m | ((unsigned)rr << 16) | ((unsigned)i << 24); L[2 * (pos + i) + 1] = (unsigned)off | ((unsigned)n << 8); }
        cnt += __shfl(pre, 63); }
    cnt = __builtin_amdgcn_readfirstlane(min(cnt, 510));
    __builtin_amdgcn_fence(__ATOMIC_RELEASE, "wavefront"); __builtin_amdgcn_wave_barrier(); __builtin_amdgcn_fence(__ATOMIC_ACQUIRE, "wavefront");
    const bool b0_ = lane & 1, b1_ = lane & 2, b2_ = lane & 4; const int myrow_ = 4 * (int)b0_ + 2 * (int)b1_ + (int)b2_; const unsigned lane16 = 16u * (unsigned)lane;
#define PH_ENT(k_, m_, off_, n_, hf_) do { const int kc_ = min((k_), cnt - 1); const unsigned e0_ = (unsigned)__builtin_amdgcn_readfirstlane((int)L[2 * kc_]), e1_ = (unsigned)__builtin_amdgcn_readfirstlane((int)L[2 * kc_ + 1]); m_ = (int)(e0_ & 0xffffu); hf_ = (int)(e0_ >> 24); off_ = (int)(e1_ & 255u); n_ = (int)(e1_ >> 8); } while (0)
#define PH_PW(k_, dst_) do { int m_, off_, n_, hf_; PH_ENT((k_), m_, off_, n_, hf_); dst_ = PLR[(size_t)m_ * 128 + min(off_ + min(gbase + 8 * hf_ + myrow_, max(n_ - 1, 0)), 127)]; } while (0)
#define PH_ROWS(S_, k_) do { int m_, off_, n_, hf_; PH_ENT((k_), m_, off_, n_, hf_); asm volatile("v_mov_b32 %0, %1" : "=v"(S_.pw) : "v"(S_.pwn));     \
        const int eo_ = (n_ > gbase + 8 * hf_ + myrow_) ? (int)(S_.pw >> 16) : 0; S_.su = SU[eo_]; S_.sv = SV[eo_]; S_.sh = ((const float*)(ws + WS_SH))[m_]; \
        _Pragma("unroll") for (int i = 0; i < 8; ++i) { const int li_ = ((i & 1) << 2) | (i & 2) | (i >> 2); const unsigned rl_ = (unsigned)__builtin_amdgcn_readlane(eo_, li_); const unsigned ro_ = rl_ * 1024u + lane16; S_.W[i] = *(const v4u*)(U8 + ro_); } \
        S_.h0 = *(const v4u*)(ws + WS_HF8 + ((unsigned)m_ * 1024u + lane16)); } while (0)
#define PH_PROC(S_, k_) do { int m_, off_, n_, hf_; PH_ENT((k_), m_, off_, n_, hf_); int f_[8]; \
        _Pragma("unroll") for (int i = 0; i < 8; ++i) { int dh; asm("v_dot4_i32_i8 %0, %1, %2, 0" : "=v"(dh) : "v"(S_.W[i].x), "v"(S_.h0.x));     dh = __builtin_amdgcn_sdot4((int)S_.W[i].y, (int)S_.h0.y, dh, false); dh = __builtin_amdgcn_sdot4((int)S_.W[i].z, (int)S_.h0.z, dh, false); f_[i] = __builtin_amdgcn_sdot4((int)S_.W[i].w, (int)S_.h0.w, dh, false); } \
        int h_[4], p_[2]; \
        _Pragma("unroll") for (int k2 = 0; k2 < 4; ++k2) { const int mine = b0_ ? f_[k2 + 4] : f_[k2], send = b0_ ? f_[k2] : f_[k2 + 4]; h_[k2] = mine + __builtin_amdgcn_update_dpp(0, send, 0xB1, 0xF, 0xF, true); } \
        _Pragma("unroll") for (int k2 = 0; k2 < 2; ++k2) { const int mine = b1_ ? h_[k2 + 2] : h_[k2], send = b1_ ? h_[k2] : h_[k2 + 2]; p_[k2] = mine + __builtin_amdgcn_update_dpp(0, send, 0x4E, 0xF, 0xF, true); } \
          \
        int t_ = __builtin_amdgcn_update_dpp(0, p_[0], 0x104, 0xF, 0x5, false); t_ = __builtin_amdgcn_update_dpp(t_, p_[1], 0x114, 0xF, 0xA, false); \
        int qi_ = (b2_ ? p_[1] : p_[0]) + t_; qi_ += __builtin_amdgcn_update_dpp(0, qi_, 0x128, 0xF, 0xF, true); \
        { const auto r_ = __builtin_amdgcn_permlane16_swap((unsigned)qi_, (unsigned)qi_, false, false); qi_ = (int)(r_[0] + r_[1]); } \
        { const auto r_ = __builtin_amdgcn_permlane32_swap((unsigned)qi_, (unsigned)qi_, false, false); qi_ = (int)(r_[0] + r_[1]); } \
        const int idx = gbase + 8 * hf_ + myrow_; \
        const float aw = __uint_as_float(S_.pw << 16) * gelu_tanh((float)qi_ * S_.su * S_.sh) * S_.sv; \
        unsigned* dst = (lane < 8 && idx < n_) ? (unsigned*)(ws + WS_PL) + ((size_t)(m_ >> 6) * 128 + off_ + idx) * 64 + (m_ & 63) : dump; const unsigned ab_ = __float_as_uint(aw); *dst = ((S_.pw >> 16) << 3) | (((ab_ + 0xffffu + ((ab_ >> 17) & 1u)) >> 17) << 17); } while (0)
    PhSet S0, S1, S2, S3;
    PH_PW(0, S0.pwn); PH_PW(1, S1.pwn); PH_PW(2, S2.pwn); PH_PW(3, S3.pwn);
    PH_ROWS(S0, 0); PH_PW(4, S0.pwn); PH_ROWS(S1, 1); PH_PW(5, S1.pwn); PH_ROWS(S2, 2); PH_PW(6, S2.pwn);
    __builtin_amdgcn_s_waitcnt(0x0F70);
#pragma nounroll
    for (int k = 0; k < cnt; k += 4) {
        PH_ROWS(S3, k + 3); PH_PW(k + 7, S3.pwn); PH_PROC(S0, k);
        PH_ROWS(S0, k + 4); PH_PW(k + 8, S0.pwn); PH_PROC(S1, k + 1);
        PH_ROWS(S1, k + 5); PH_PW(k + 9, S1.pwn); PH_PROC(S2, k + 2);
        PH_ROWS(S2, k + 6); PH_PW(k + 10, S2.pwn); PH_PROC(S3, k + 3);
    }
#undef PH_ENT
#undef PH_PW
#undef PH_ROWS
#undef PH_PROC
    __builtin_amdgcn_wave_barrier();
}
__device__ __forceinline__ void peer_u_exceptions(const Args& a, const Ctx& X) {
    const gu32* ctl = (const gu32*)(a.ws + WS_CTL); const int nexc = min((int)__hip_atomic_load(ctl + CW_NEXC, RLX_AGENT), EXC_CAP);
    for (int i = X.bid * NWAVES + X.wave; i < nexc; i += X.G * NWAVES) { const unsigned ent = __hip_atomic_load(ctl + CW_EXC + i, RLX_AGENT); const int m = (int)(ent >> 4), rr = 2 * (int)(ent & 15u);
        const unsigned char* offp = a.ws + WS_OFF + (size_t)m * 32; const int n = (int)offp[rr + 2] - (int)offp[rr];
        for (int gb = 8 * HU_MAX; gb < n; gb += 8 * HU_MAX) peer_u_pass2(a, X.lds, X.wave, m, M_TOK, 1, rr, gb, X.lane); }
}
__device__ __forceinline__ void p10u_xcd(const Args& a, const Ctx& X, int xcc, int rank) {
    const gu32* ctl = (const gu32*)(a.ws + WS_CTL); const gu32* xr = ctl + CW_XR;
    int cnt[8];
#pragma unroll
    for (int j = 0; j < 8; ++j) cnt[j] = (int)__hip_atomic_load(xr + 64 * j, RLX_AGENT);
    const bool overflow = (int)__hip_atomic_load(ctl + CW_NEXC, RLX_AGENT) > EXC_CAP;
    if (xcc < 8) { int nl = 1;
#pragma unroll
        for (int j = 0; j < 8; ++j) nl = (j == xcc) ? cnt[j] : nl;
        if (nl < 1) nl = 1;
        peer_u_pass2(a, X.lds, X.wave, rank * NWAVES + X.wave, nl * NWAVES, 1, 2 * xcc, 0, X.lane);
        if (overflow) for (int gb = 8 * HU_MAX; gb < 128; gb += 8 * HU_MAX) peer_u_pass2(a, X.lds, X.wave, rank * NWAVES + X.wave, nl * NWAVES, 1, 2 * xcc, gb, X.lane); }
#pragma nounroll
    for (int j = 0; j < 8; ++j) { int cj = 1;
#pragma unroll
        for (int q = 0; q < 8; ++q) cj = (q == j) ? cnt[q] : cj;
        if (cj == 0) { peer_u_pass2(a, X.lds, X.wave, X.bid * NWAVES + X.wave, X.G * NWAVES, 1, 2 * j, 0, X.lane);
            if (overflow) for (int gb = 8 * HU_MAX; gb < 128; gb += 8 * HU_MAX) peer_u_pass2(a, X.lds, X.wave, X.bid * NWAVES + X.wave, X.G * NWAVES, 1, 2 * j, gb, X.lane); } }
    if (!overflow) peer_u_exceptions(a, X);
}
__device__ __forceinline__ void p10_peer(const Args& a, const Ctx& X) {
    for (int i = X.tid; i < 512; i += 512) *(LAS unsigned*)(X.lds + PE_HZ + 4 * i) = 0u;
    for (int i = X.tid; i < 256 * 64; i += 512) { const int r = i >> 6, c2 = i & 63; const float2 v = ((const float2*)a.in[16])[i]; *(LAS unsigned*)(X.lds + PE_SK + r * PE_SK_ROW + 4 * c2) = pk2(v.x, v.y); }
    for (int it = X.bid; it < M_TOK / 16; it += X.G) { const int m0 = it * 16;
        __syncthreads();
        peer_route16(a, X.lds, m0, X.wave, X.lane);
        __syncthreads();
        peer_emit1(a, X.lds, m0 + 2 * X.wave, 2 * X.wave, X.lane); peer_emit1(a, X.lds, m0 + 2 * X.wave + 1, 2 * X.wave + 1, X.lane);
    }
}

__device__ __forceinline__ void p11_vslice(const Args& a, const Ctx& X) {
    unsigned char* ws = a.ws; typedef float f32x2w __attribute__((ext_vector_type(2)));
    for (int vw = X.bid; vw < 256; vw += X.G) { const int xg = vw & 7, li = vw >> 3, slice = 16 * xg + (li & 15), hf = li >> 4;
        float gi[8];
#pragma unroll
        for (int i = 0; i < 8; ++i) gi[i] = 1.f / a.in[14][8 * slice + i];
        __syncthreads();
        for (int i = X.tid; i < 16384; i += 512) *(LAS unsigned long long*)(X.lds + 8 * i) = *(const unsigned long long*)(ws + WS_V8 + (size_t)i * 1024 + 8 * slice);
        __syncthreads();
        for (int tgi = X.wave; tgi < 128; tgi += NWAVES) { const int tg = hf * 128 + tgi; const unsigned* pl = (const unsigned*)(ws + WS_PL) + (size_t)tg * 128 * 64 + X.lane;
            f32x2w acc0 = {0.f, 0.f}, acc1 = acc0, acc2 = acc0, acc3 = acc0;
            unsigned pa[8], pb[8];
#define VS_LD(P_, k_) do { _Pragma("unroll") for (int u = 0; u < 8; ++u) P_[u] = pl[(min((k_), 120) + u) * 64]; } while (0)
#define VS_USE(P_) do { _Pragma("unroll") for (int u = 0; u < 8; ++u) { const float w = __uint_as_float(P_[u] & 0xfffe0000u); const v2u q = *(const LAS v2u*)(X.lds + (P_[u] & 0x1ffffu)); const f32x2w w2 = {w, w}; \
                    acc0 += w2 * __builtin_amdgcn_cvt_pk_f32_fp8((int)q.x, false); acc1 += w2 * __builtin_amdgcn_cvt_pk_f32_fp8((int)q.x, true); \
                    acc2 += w2 * __builtin_amdgcn_cvt_pk_f32_fp8((int)q.y, false); acc3 += w2 * __builtin_amdgcn_cvt_pk_f32_fp8((int)q.y, true); } } while (0)
            VS_LD(pa, 0);
#pragma nounroll
            for (int k0 = 0; k0 < 128; k0 += 16) { VS_LD(pb, k0 + 8); VS_USE(pa); VS_LD(pa, k0 + 16); VS_USE(pb); }
#undef VS_LD
#undef VS_USE
            f32x4* orow = (f32x4*)(a.out + ((size_t)tg * 64 + X.lane) * DM + 8 * slice);
            const v4u hbv = *(const v4u*)((const bf16*)(ws + WS_HN) + ((size_t)tg * 64 + X.lane) * DM + 8 * slice);
            const f32x4 h0 = {bflo(hbv.x) * gi[0] + acc0[0], bfhi(hbv.x) * gi[1] + acc0[1], bflo(hbv.y) * gi[2] + acc1[0], bfhi(hbv.y) * gi[3] + acc1[1]};
            const f32x4 h1 = {bflo(hbv.z) * gi[4] + acc2[0], bfhi(hbv.z) * gi[5] + acc2[1], bflo(hbv.w) * gi[6] + acc3[0], bfhi(hbv.w) * gi[7] + acc3[1]};
            orow[0] = h0; orow[1] = h1; }
    }
}

constexpr int N_PHASES = 13;
__global__ void __launch_bounds__(NWAVES * 64, 2) mega_fwd(Args args) {
    extern __shared__ __attribute__((aligned(16))) unsigned char lds[];
    Ctx X; X.lds = (LAS unsigned char*)lds; X.tid = threadIdx.x; X.lane = X.tid & 63; X.wave = __builtin_amdgcn_readfirstlane(X.tid >> 6); X.G = gridDim.x; X.bid = blockIdx.x;
    volatile LAS unsigned* MISC = (volatile LAS unsigned*)(X.lds + MISC_OFF);
    unsigned char* ws = args.ws;
    for (int u = X.tid; u < (LDS_BYTES - LDSCTL_OFF) / 4; u += NWAVES * 64) ((LAS unsigned*)(X.lds + LDSCTL_OFF))[u] = 0u;
    __syncthreads();
    XcdBarrier bar = xcd_barrier_post((unsigned*)(ws + WS_CTL) + CW_BAR, MISC + 8);
    if (X.tid == 0) { const unsigned xc = xb_xcc_id(); MISC[12] = xc; MISC[13] = __hip_atomic_fetch_add((gu32*)(ws + WS_CTL) + CW_XR + 64 * (xc & 7u), 1u, RLX_AGENT); }
    const int lo = args.ph_lo, hi = args.ph_hi;
#define IN(k) (lo <= (k) && (k) < hi)
#define SEAM(k) do { if (IN(k) && IN((k) + 1)) xcd_barrier(bar); FRESH(); } while (0)
#define FRESH() do { int t_ = threadIdx.x; asm volatile("" : "+v"(t_)); X.tid = t_; X.lane = t_ & 63; X.wave = __builtin_amdgcn_readfirstlane(t_ >> 6); } while (0)

    if (IN(0)) { p0_prologue(args, X); }
    SEAM(0);
    if (IN(1)) { auto run_ = [&]() __attribute__((always_inline)) {
        pg8::Gemm g{(const pg8::bf16_t*)args.out, (const pg8::bf16_t*)(ws + WS_WIN), M_TOK, N_PROJ, 1024, 1024, 1024}; pg8::StaticOrder S; S.init(M_TOK, N_PROJ, X.G, X.bid);
        pg8::EpiP8<ProjEpiF> E{{(bf16*)(ws + WS_PROJ), ws + WS_GATE, (float*)(ws + WS_GN)}};
        pg8::gemm_phase<pg8::EpiP8<ProjEpiF>, pg8::StaticOrder, true, true>(X.lds + RING_OFF, g, S, E);
        pg8::Gemm g8{(const pg8::bf16_t*)((const unsigned char*)args.out + XN8_OFF), (const pg8::bf16_t*)(ws + WS_WIN8), M_TOK, N1 - N_PROJ, 512, 512, 512}; pg8::StaticOrder S8; S8.init(M_TOK, N1 - N_PROJ, X.G, X.G - 1 - X.bid);
        pg8::EpiP8<ProjEpiG8> E8{{{(bf16*)(ws + WS_PROJ), ws + WS_GATE, (float*)(ws + WS_GN)}}};
        pg8::gemm_phase<pg8::EpiP8<ProjEpiG8>, pg8::StaticOrder, true, true, true>(X.lds + RING_OFF, g8, S8, E8);
        }; run_(); }
    SEAM(1);
    if (IN(2)) p2_prep(args, X);
    SEAM(2);
    if (IN(3)) { auto run_ = [&]() __attribute__((always_inline)) {
        if (X.bid < 16) {
        pg8::Gemm g{(const pg8::bf16_t*)(ws + WS_KCVC), (const pg8::bf16_t*)(ws + WS_W1), 4096, 512, 2048, 1024, 2048}; pg8::ListOrder S{16, 8, X.G, X.bid};
        CmpFusedEpi E{(const float*)(ws + WS_BIAS), (const bf16*)(ws + WS_W2T), args.in[4], (const float2*)(ws + WS_ROPE), (bf16*)(ws + WS_KC16), (bf16*)(ws + WS_VC16)};
        pg8::gemm_phase<CmpFusedEpi, pg8::ListOrder, false, true>(X.lds + RING_OFF, g, S, E);
        } else p3_sb(args, X, X.bid - 16, X.G - 16);
        }; run_(); }
    SEAM(3);
    if (IN(5)) { p5_mixers(args, X); }
    SEAM(5);
    if (IN(6)) { auto run_ = [&]() __attribute__((always_inline)) {
        pg8::Gemm g{(const pg8::bf16_t*)(ws + WS_ONSA), (const pg8::bf16_t*)(ws + WS_WA), 2 * M_TOK, 2048, 256, 256, 256}; MergeOrder S; S.S0.init(M_TOK, 1024, X.G, X.bid);
        pg8::EpiN4<MergeEpiF> E{{ws + WS_GATE, (bf16*)(ws + WS_MERGED), ws + WS_M8}};
        pg8::gemm_phase<pg8::EpiN4<MergeEpiF>, MergeOrder, true, true, true>(X.lds + RING_OFF, g, S, E);
        }; run_(); }
    SEAM(6);
    if (IN(7)) { auto run_ = [&]() __attribute__((always_inline)) {
        pg8::Gemm g{(const pg8::bf16_t*)(ws + WS_M8), (const pg8::bf16_t*)(ws + WS_WO), M_TOK, 1024, 512, 512, 512}; pg8::StaticOrder S; S.init(M_TOK, 1024, X.G, X.bid);
        OutNormEpi E{args.in[0], args.out, (bf16*)(ws + WS_HN), args.in[14], (float*)(ws + WS_ROWSS)};
        pg8::gemm_phase<OutNormEpi, pg8::StaticOrder, true, true, true>(X.lds + RING_OFF, g, S, E);
        }; run_(); }
    SEAM(7);
    if (IN(9)) { auto run_ = [&]() __attribute__((always_inline)) {
        pg8::Gemm g{(const pg8::bf16_t*)(ws + WS_HN), (const pg8::bf16_t*)(ws + WS_WQ), M_TOK, 2048, 1024, 1024, 1024}; pg8::StaticOrder S; S.init(M_TOK, 2048, X.G, X.bid);
        QpNormEpi E{(bf16*)(ws + WS_QP), (const float*)(ws + WS_ROWSS)};
        pg8::gemm_phase<QpNormEpi, pg8::StaticOrder, true, true>(X.lds + RING_OFF, g, S, E);
        }; run_(); }
    SEAM(9);
    if (IN(10)) p10_peer(args, X);
    SEAM(10);
    if (IN(11)) { p10u_xcd(args, X, (int)MISC[12], (int)MISC[13]); }
    SEAM(11);
    if (IN(12)) p11_vslice(args, X);
#undef IN
#undef SEAM
}

extern "C" void kernel_launch(void* const* d_in, const int* in_sizes, int n_in, void* d_out, int out_size, void* d_ws, size_t ws_size, hipStream_t stream) {
    static int grid = 0;
    if (grid == 0) {
        int dev = 0, cus = 0, per_cu = 0;
        if (hipGetDevice(&dev) != hipSuccess || hipDeviceGetAttribute(&cus, hipDeviceAttributeMultiprocessorCount, dev) != hipSuccess) { fprintf(stderr, "kernel_launch: device query failed\n"); grid = -1; return; }
        if (hipFuncSetAttribute((const void*)mega_fwd, hipFuncAttributeMaxDynamicSharedMemorySize, LDS_BYTES) != hipSuccess) { fprintf(stderr, "kernel_launch: hipFuncSetAttribute failed\n"); grid = -1; return; }
        if (hipOccupancyMaxActiveBlocksPerMultiprocessor(&per_cu, (const void*)mega_fwd, NWAVES * 64, LDS_BYTES) != hipSuccess || per_cu < 1) { fprintf(stderr, "kernel_launch: occupancy query says %d\n", per_cu); }
        (void)hipGetLastError();
        grid = cus;
        if (ws_size < 256 * MiB) fprintf(stderr, "kernel_launch: workspace too small: %zu\n", ws_size);
    }
    if (grid < 0) return;
    (void)hipMemsetAsync((char*)d_ws + WS_CTL, 0, CTL_ZERO_BYTES, stream);
    Args a{};
    for (int i = 0; i < 19; ++i) a.in[i] = (const float*)d_in[i];
    a.out = (float*)d_out; a.ws = (unsigned char*)d_ws;
    a.ph_lo = 0; a.ph_hi = N_PHASES;
    hipLaunchKernelGGL(mega_fwd, dim3(grid), dim3(NWAVES * 64), LDS_BYTES, stream, a);
}
```

```cpp
#include <hip/hip_runtime.h>
#include <cstdio>
#include <cstdint>
#include <cmath>

constexpr int HU_MAX = 4;
namespace pg8 {
#define PG8_LAS __attribute__((address_space(3)))
typedef unsigned short bf16_t;
typedef short bf16x8 __attribute__((ext_vector_type(8)));
typedef float f32x4 __attribute__((ext_vector_type(4)));
typedef unsigned u32x4 __attribute__((ext_vector_type(4)));
typedef int i32x4 __attribute__((ext_vector_type(4)));
constexpr int BM = 256, BK = 64, HALF = 128, HTB = HALF * BK * 2  , STAGE_BYTES = 8 * HTB, NXCD = 8, WGM = 8;

__host__ __device__ __forceinline__ int lds_byte(int r, int c) { const int st = (r >> 4) * 2 + (c >> 5), rr = r & 15, cc = c & 31, ob = rr * 64 + cc * 2; return st * 1024 + (ob ^ (((ob >> 9) & 1) << 5)); }
__host__ __device__ __forceinline__ void stage_rc(int b, int& R, int& C) { const int st = b / 1024, sb = b % 1024, swz = sb ^ (((sb >> 9) & 1) << 5); R = (st >> 1) * 16 + swz / 64; C = (st & 1) * 32 + (swz % 64) / 2; }
__host__ __device__ __forceinline__ int perm32(int rho) { const int n = rho >> 4, i = rho & 15; return 8 * (i >> 2) + 4 * n + (i & 3); }

struct Unit { int pm, pn; };
struct Gemm { const bf16_t* A; const bf16_t* Bt; int M, N, K, lda, ldb; };

struct StaticOrder {
    int nM, nN, nwg, G, c;
    __host__ __device__ void init(int M, int N, int G_, int c_) { nM = M / BM; nN = N / BM; nwg = nM * nN; G = G_; c = c_; }
    __host__ __device__ bool next(int i, Unit& u) const {
        const long L = (long)i * G + c; if (L >= nwg) return false;
        int wgid = (int)L; { const int q = nwg / NXCD, r = nwg % NXCD, xcd = wgid % NXCD, off = wgid / NXCD; wgid = (xcd < r ? xcd * (q + 1) : r * (q + 1) + (xcd - r) * q) + off; }
        const int nig = WGM * nN, gid = wgid / nig, fm = gid * WGM, gsz = (nM - fm) < WGM ? (nM - fm) : WGM;
        u.pm = fm + ((wgid % nig) % gsz); u.pn = (wgid % nig) / gsz; return true;
    }
    __device__ __forceinline__ void a_ready(const Unit&) const {}
    __device__ __forceinline__ void done(const Unit&) const {}
};

typedef float f32x2_cv __attribute__((ext_vector_type(2))); typedef __bf16 bf16x2_cv __attribute__((ext_vector_type(2)));
__device__ __forceinline__ unsigned cvt_pk_bf16(float lo, float hi) { const f32x2_cv v = {lo, hi}; const bf16x2_cv b = __builtin_convertvector(v, bf16x2_cv); return __builtin_bit_cast(unsigned, b); }
template <class F> struct EpiP8 {
    static constexpr bool PERM = true, AFTER_DRAIN = false; F f;
    __device__ __forceinline__ void operator()(const f32x4 (&acc)[2][2][4][2], const Unit& u, int wr, int wc, int fr, int fq) const {
        const int row0 = u.pm * BM + wr * 64 + fr, col0 = u.pn * BM + wc * 32 + 8 * fq;
#pragma unroll
        for (int ai = 0; ai < 2; ++ai)
#pragma unroll
            for (int m = 0; m < 4; ++m)
#pragma unroll
                for (int bj = 0; bj < 2; ++bj) f(row0 + ai * HALF + m * 16, col0 + bj * HALF, acc[ai][bj][m][0], acc[ai][bj][m][1], u);
    }
};
template <class F> struct EpiN4 {
    static constexpr bool PERM = false, AFTER_DRAIN = false; F f;
    __device__ __forceinline__ void operator()(const f32x4 (&acc)[2][2][4][2], const Unit& u, int wr, int wc, int fr, int fq) const {
        const int row0 = u.pm * BM + wr * 64 + fr, col0 = u.pn * BM + wc * 32 + 4 * fq;
#pragma unroll
        for (int ai = 0; ai < 2; ++ai)
#pragma unroll
            for (int m = 0; m < 4; ++m)
#pragma unroll
                for (int bj = 0; bj < 2; ++bj)
#pragma unroll
                    for (int n = 0; n < 2; ++n) f(row0 + ai * HALF + m * 16, col0 + bj * HALF + n * 16, acc[ai][bj][m][n], u);
    }
};
struct ListOrder {
    int n, div, G, c;
    __device__ bool next(int i, Unit& u) const { const int L = i * G + c; if (L >= n) return false; u.pm = L; u.pn = L / div; return true; }
    __device__ __forceinline__ void a_ready(const Unit&) const {}
    __device__ __forceinline__ void done(const Unit&) const {}
};

template <class Epi, class Sched, bool ALIGN_EPI = false, bool SP2 = false, bool F8 = false>
__device__ __forceinline__ void gemm_phase(PG8_LAS unsigned char* lds, const Gemm g, const Sched& S, const Epi& E) {
    const int tid = threadIdx.x, wid = __builtin_amdgcn_readfirstlane(tid >> 6), lane = tid & 63, wr = wid >> 2, wc = wid & 3, fr = lane & 15, fq = lane >> 4;
    const int K = g.K, nt = K / BK;
    unsigned voffA[2], voffB[2];
#pragma unroll
    for (int i = 0; i < 2; ++i) { int R, C; stage_rc(tid * 16 + i * 8192, R, C); const int Rb = Epi::PERM ? ((R & ~31) + perm32(R & 31)) : R;
        voffA[i] = (unsigned)(R * g.lda + C) * 2u; voffB[i] = (unsigned)(Rb * g.ldb + C) * 2u; }
    const size_t kstep = (size_t)(BK * 2);
    const size_t hstepA = (size_t)HALF * g.lda * 2, hstepB = (size_t)HALF * g.ldb * 2;
    const size_t tstepA = 2 * hstepA, tstepB = 2 * hstepB;
    const unsigned ldsw = (unsigned)wid * 1024u;
    const int aoff = lds_byte(wr * 64 + fr, fq * 8), boff = lds_byte(wc * 32 + fr, fq * 8);
#define PG8_SA(b, h) (((b) * 2 + (h)) * HTB)
#define PG8_SB(b, h) ((4 + (b) * 2 + (h)) * HTB)
#define PG8_STAGE(bufoff, gbase, voff) do { _Pragma("unroll") for (int _i = 0; _i < 2; ++_i) \
        __builtin_amdgcn_global_load_lds((const unsigned*)((const char*)(gbase) + (voff)[_i]), (PG8_LAS unsigned*)(lds + (bufoff) + ldsw + _i * 8192), 16, 0, 0); } while (0)
#define PG8_LDA(dst, b, h) do { _Pragma("unroll") for (int m = 0; m < 4; ++m) _Pragma("unroll") for (int k = 0; k < 2; ++k) dst[m][k] = *(const PG8_LAS bf16x8*)(lds + PG8_SA(b, h) + aoff + m * 2048 + k * 1024); } while (0)
#define PG8_LDB(dst, b, h) do { _Pragma("unroll") for (int n = 0; n < 2; ++n) _Pragma("unroll") for (int k = 0; k < 2; ++k) dst[n][k] = *(const PG8_LAS bf16x8*)(lds + PG8_SB(b, h) + boff + n * 2048 + k * 1024); } while (0)
#define PG8_CAT8(x, y) __builtin_shufflevector(__builtin_bit_cast(i32x4, (x)), __builtin_bit_cast(i32x4, (y)), 0, 1, 2, 3, 4, 5, 6, 7)
#define PG8_MMA(ai, bj, At, Bt) do { __builtin_amdgcn_s_setprio(1); if constexpr (F8) { _Pragma("unroll") for (int m = 0; m < 4; ++m) _Pragma("unroll") for (int n = 0; n < 2; ++n) \
        asm volatile("v_mfma_f32_16x16x128_f8f6f4 %0, %1, %2, %0" : "+v"(acc[ai][bj][m][n]) : "v"(PG8_CAT8(Bt[n][0], Bt[n][1])), "v"(PG8_CAT8(At[m][0], At[m][1]))); } else {     \
        _Pragma("unroll") for (int m = 0; m < 4; ++m) _Pragma("unroll") for (int n = 0; n < 2; ++n) _Pragma("unroll") for (int k = 0; k < 2; ++k) \
        acc[ai][bj][m][n] = __builtin_amdgcn_mfma_f32_16x16x32_bf16(Bt[n][k], At[m][k], acc[ai][bj][m][n], 0, 0, 0); } __builtin_amdgcn_s_setprio(0); } while (0)
#define PG8_WAIT_V(n) asm volatile("s_waitcnt vmcnt(" #n ")" ::: "memory")
#define PG8_WAIT_L(n) asm volatile("s_waitcnt lgkmcnt(" #n ")" ::: "memory")
#define PG8_BAR __builtin_amdgcn_s_barrier()
#define PG8_SCHED __builtin_amdgcn_sched_barrier(0)
    Unit cur, nxt; int ui = 0;
    if (!S.next(0, cur)) return;
    f32x4 acc[2][2][4][2];
#pragma unroll
    for (int a = 0; a < 2; ++a)
#pragma unroll
        for (int b = 0; b < 2; ++b)
#pragma unroll
            for (int m = 0; m < 4; ++m)
#pragma unroll
                for (int n = 0; n < 2; ++n) acc[a][b][m][n] = (f32x4){0.f, 0.f, 0.f, 0.f};
    bf16x8 At[4][2], B0[2][2], B1[2][2];
    const char* cA = (const char*)g.A + (size_t)cur.pm * tstepA; const char* cB = (const char*)g.Bt + (size_t)cur.pn * tstepB;
    S.a_ready(cur);
    if constexpr (SP2) {
        PG8_STAGE(PG8_SB(0, 0), cB, voffB); PG8_STAGE(PG8_SB(0, 1), cB + hstepB, voffB); PG8_STAGE(PG8_SA(0, 0), cA, voffA); PG8_STAGE(PG8_SA(0, 1), cA + hstepA, voffA);
        if (wr == 1) PG8_BAR;
        PG8_WAIT_V(2); PG8_BAR;
        PG8_STAGE(PG8_SB(1, 0), cB + kstep, voffB); PG8_STAGE(PG8_SA(1, 0), cA + kstep, voffA); PG8_STAGE(PG8_SB(1, 1), cB + hstepB + kstep, voffB);
        PG8_WAIT_V(6); PG8_BAR;
    } else {
        PG8_STAGE(PG8_SB(0, 0), cB, voffB); PG8_STAGE(PG8_SA(0, 0), cA, voffA); PG8_STAGE(PG8_SB(0, 1), cB + hstepB, voffB); PG8_STAGE(PG8_SA(0, 1), cA + hstepA, voffA);
        if (wr == 1) PG8_BAR;
        PG8_WAIT_V(4); PG8_BAR;
        PG8_STAGE(PG8_SB(1, 0), cB + kstep, voffB); PG8_STAGE(PG8_SA(1, 0), cA + kstep, voffA); PG8_STAGE(PG8_SB(1, 1), cB + hstepB + kstep, voffB);
        PG8_WAIT_V(6); PG8_BAR;
    }
    for (;;) {
        const bool has_next = S.next(ui + 1, nxt);
        const char* nA = has_next ? (const char*)g.A + (size_t)nxt.pm * tstepA : cA; const char* nB = has_next ? (const char*)g.Bt + (size_t)nxt.pn * tstepB : cB;
#pragma nounroll
        for (int t = 0; t < nt; t += 2) {
            const bool last = (t == nt - 2);
            const char* a1 = cA + (size_t)(t + 1) * kstep;
            const char* a2 = last ? nA : cA + (size_t)(t + 2) * kstep; const char* b2 = last ? nB : cB + (size_t)(t + 2) * kstep;
            const char* a3 = a2 + kstep; const char* b3 = b2 + kstep;
            if (last && has_next) S.a_ready(nxt);
            if constexpr (SP2) {
            PG8_LDB(B0, 0, 0); PG8_LDB(B1, 0, 1); PG8_SCHED; PG8_LDA(At, 0, 0); PG8_STAGE(PG8_SA(1, 1), a1 + hstepA, voffA);
            PG8_WAIT_V(8); PG8_WAIT_L(0); PG8_BAR; PG8_MMA(0, 0, At, B0); PG8_MMA(0, 1, At, B1); PG8_BAR; PG8_SCHED;
            PG8_LDA(At, 0, 1); PG8_STAGE(PG8_SB(0, 0), b2, voffB); PG8_STAGE(PG8_SB(0, 1), b2 + hstepB, voffB); PG8_STAGE(PG8_SA(0, 0), a2, voffA);
            PG8_WAIT_V(8); PG8_WAIT_L(0); PG8_BAR; PG8_MMA(1, 0, At, B0); PG8_MMA(1, 1, At, B1); PG8_BAR; PG8_SCHED;
            PG8_LDB(B0, 1, 0); PG8_LDB(B1, 1, 1); PG8_SCHED; PG8_LDA(At, 1, 0); PG8_STAGE(PG8_SA(0, 1), a2 + hstepA, voffA);
            PG8_WAIT_V(8); PG8_WAIT_L(0); PG8_BAR; PG8_MMA(0, 0, At, B0); PG8_MMA(0, 1, At, B1); PG8_BAR; PG8_SCHED;
            PG8_LDA(At, 1, 1); PG8_STAGE(PG8_SB(1, 0), b3, voffB); PG8_STAGE(PG8_SB(1, 1), b3 + hstepB, voffB); PG8_STAGE(PG8_SA(1, 0), a3, voffA);
            PG8_WAIT_V(8); PG8_WAIT_L(0); PG8_BAR; PG8_MMA(1, 0, At, B0); PG8_MMA(1, 1, At, B1); PG8_BAR; PG8_SCHED;
            } else {
            PG8_LDB(B0, 0, 0); PG8_SCHED; PG8_LDA(At, 0, 0); PG8_STAGE(PG8_SA(1, 1), a1 + hstepA, voffA);
            PG8_WAIT_L(8); PG8_BAR; PG8_WAIT_L(0); PG8_MMA(0, 0, At, B0); PG8_BAR; PG8_SCHED;
            PG8_LDB(B1, 0, 1); PG8_STAGE(PG8_SB(0, 0), b2, voffB);
            PG8_BAR; PG8_WAIT_L(0); PG8_MMA(0, 1, At, B1); PG8_BAR;
            PG8_LDA(At, 0, 1); PG8_STAGE(PG8_SA(0, 0), a2, voffA);
            PG8_BAR; PG8_WAIT_L(0); PG8_MMA(1, 0, At, B0); PG8_BAR; PG8_SCHED;
            PG8_STAGE(PG8_SB(0, 1), b2 + hstepB, voffB);
            PG8_WAIT_V(6); PG8_BAR; PG8_MMA(1, 1, At, B1); PG8_BAR;
            PG8_LDB(B0, 1, 0); PG8_SCHED; PG8_LDA(At, 1, 0); PG8_STAGE(PG8_SA(0, 1), a2 + hstepA, voffA);
            PG8_WAIT_L(8); PG8_BAR; PG8_WAIT_L(0); PG8_MMA(0, 0, At, B0); PG8_BAR; PG8_SCHED;
            PG8_LDB(B1, 1, 1); PG8_STAGE(PG8_SB(1, 0), b3, voffB);
            PG8_BAR; PG8_WAIT_L(0); PG8_MMA(0, 1, At, B1); PG8_BAR;
            PG8_LDA(At, 1, 1); PG8_STAGE(PG8_SA(1, 0), a3, voffA);
            PG8_BAR; PG8_WAIT_L(0); PG8_MMA(1, 0, At, B0); PG8_BAR; PG8_SCHED;
            PG8_STAGE(PG8_SB(1, 1), b3 + hstepB, voffB);
            PG8_WAIT_V(6); PG8_BAR; PG8_MMA(1, 1, At, B1); PG8_BAR;
            }
        }
        if constexpr (F8) { asm volatile("s_nop 15\n\ts_nop 15" ::: "memory"); }
        if constexpr (ALIGN_EPI) { if (wr == 0) PG8_BAR; }
        if constexpr (!Epi::AFTER_DRAIN) { E(acc, cur, wr, wc, fr, fq); S.done(cur); }
        if (!has_next) break;
#pragma unroll
        for (int a = 0; a < 2; ++a)
#pragma unroll
            for (int b = 0; b < 2; ++b)
#pragma unroll
                for (int m = 0; m < 4; ++m)
#pragma unroll
                    for (int n = 0; n < 2; ++n) acc[a][b][m][n] = (f32x4){0.f, 0.f, 0.f, 0.f};
        cur = nxt; cA = nA; cB = nB; ++ui;
        if constexpr (ALIGN_EPI) { if (wr == 1) PG8_BAR; }
    }
    PG8_WAIT_V(0);
    if constexpr (!ALIGN_EPI) { if (wr == 0) PG8_BAR; }
    PG8_BAR;
    if constexpr (Epi::AFTER_DRAIN) { E.fused(acc, cur, wr, wc, fr, fq, lds, wid, lane); S.done(cur); }
#undef PG8_SA
#undef PG8_SB
#undef PG8_STAGE
#undef PG8_LDA
#undef PG8_LDB
#undef PG8_MMA
#undef PG8_CAT8
#undef PG8_WAIT_V
#undef PG8_WAIT_L
#undef PG8_BAR
#undef PG8_SCHED
}
}

constexpr int NWAVES = 8;
constexpr int M_TOK = 16384, SEQ = 8192, DM = 1024;
constexpr int PJ = 2816;
constexpr int N1 = 5120;
constexpr int N_PROJ = 2816;
constexpr size_t XN8_OFF = (size_t)32 << 20;
constexpr int C_KV = 512, C_SB = 1280;
constexpr float EPS = 1e-6f;

constexpr size_t MiB = 1u << 20;
constexpr size_t WS_PROJ = 0;
constexpr size_t WS_QP = 96 * MiB;
constexpr size_t WS_ROPE = 88 * MiB;
constexpr size_t WS_GN = 90 * MiB;
constexpr size_t WS_SEL = 92 * MiB;
constexpr size_t WS_KC = 94 * MiB;
constexpr size_t WS_VC = 94 * MiB + 512 * 1024;
constexpr size_t WS_BIAS = 95 * MiB;
constexpr size_t WS_KC16 = 95 * MiB + 65536, WS_VC16 = WS_KC16 + 262144;
constexpr size_t WS_GATE = 96 * MiB;
constexpr size_t WS_U16 = 96 * MiB, WS_V16 = 128 * MiB;
constexpr size_t WS_U8 = 192 * MiB, WS_V8 = 208 * MiB, WS_SU = 255 * MiB + 655360, WS_SVS = 255 * MiB + 720896;
constexpr size_t WS_PL = 64 * MiB;
constexpr size_t WS_PLR = 72 * MiB, WS_OFF = 80 * MiB, WS_HF8 = 160 * MiB;
constexpr size_t WS_ROWSS = 82 * MiB;
constexpr size_t WS_SH = 81 * MiB;
constexpr int CW_NEXC = 96, CW_EXC = 8192, EXC_CAP = 4096;
constexpr int CW_XR = 128;
constexpr size_t WS_W2T = 93 * MiB + 131072;
constexpr size_t WS_SK16 = 93 * MiB;
constexpr size_t WS_ONSA = 160 * MiB, WS_OSB = 176 * MiB;
constexpr size_t WS_D = 192 * MiB;
constexpr size_t WS_KCVC = WS_D, WS_H = WS_D + 10 * MiB;
constexpr size_t WS_M8 = 64 * MiB;
constexpr size_t WS_MERGED = 0, WS_HN = 32 * MiB;
constexpr size_t WS_WIN8 = 230 * MiB;
constexpr size_t WS_WIN = 224 * MiB, WS_WA = 234 * MiB, WS_WB = 235 * MiB, WS_WO = 236 * MiB, WS_WQ = 238 * MiB, WS_W1 = 242 * MiB;
constexpr size_t WS_CTL = 255 * MiB, CTL_ZERO_BYTES = 1 * MiB;
constexpr int CW_BAR = 4096;
constexpr int CW_CHK = 64;
constexpr float QSCALE = 0.125f * 1.4426950408889634f;

constexpr int RING_OFF = 0, RING_BYTES = 131072;
constexpr int LDSCTL_OFF = 150528, MISC_OFF = LDSCTL_OFF + 320;
constexpr int LDS_BYTES = 151552;

#define GAS __attribute__((address_space(1)))
#define LAS __attribute__((address_space(3)))
typedef unsigned short bf16;
typedef unsigned v4u __attribute__((ext_vector_type(4)));
typedef unsigned v2u __attribute__((ext_vector_type(2)));
typedef float f32x4 __attribute__((ext_vector_type(4)));
typedef GAS unsigned gu32;
#define RLX_AGENT __ATOMIC_RELAXED, __HIP_MEMORY_SCOPE_AGENT
#define LDS_WAIT() asm volatile("s_waitcnt lgkmcnt(0)" ::: "memory")
__device__ __forceinline__ unsigned f2bf(float f) { unsigned u = __builtin_bit_cast(unsigned, f); return (u + 0x7fffu + ((u >> 16) & 1u)) >> 16; }
__device__ __forceinline__ unsigned pk2(float lo, float hi) { return f2bf(lo) | (f2bf(hi) << 16); }
__device__ __forceinline__ float bf2f(unsigned h) { return __builtin_bit_cast(float, h << 16); }
__device__ __forceinline__ float bflo(unsigned w) { return __builtin_bit_cast(float, w << 16); }
__device__ __forceinline__ float bfhi(unsigned w) { return __builtin_bit_cast(float, w & 0xffff0000u); }
__device__ __forceinline__ unsigned pack4_fp8(float x0, float x1, float x2, float x3) { int w = __builtin_amdgcn_cvt_pk_fp8_f32(x0, x1, 0, false); w = __builtin_amdgcn_cvt_pk_fp8_f32(x2, x3, w, true); return (unsigned)w; }

#define XL_DPP(v_, ctrl_) __uint_as_float((unsigned)__builtin_amdgcn_update_dpp(0, (int)__float_as_uint(v_), (ctrl_), 0xF, 0xF, true))
__device__ __forceinline__ float xl_swap16(float v) { const auto r = __builtin_amdgcn_permlane16_swap(__float_as_uint(v), __float_as_uint(v), false, false); return __uint_as_float(r[0]) + __uint_as_float(r[1]); }
__device__ __forceinline__ float xl_swap32(float v) { const auto r = __builtin_amdgcn_permlane32_swap(__float_as_uint(v), __float_as_uint(v), false, false); return __uint_as_float(r[0]) + __uint_as_float(r[1]); }
__device__ __forceinline__ float xl_max16(float v) { const auto r = __builtin_amdgcn_permlane16_swap(__float_as_uint(v), __float_as_uint(v), false, false); return fmaxf(__uint_as_float(r[0]), __uint_as_float(r[1])); }
__device__ __forceinline__ float xl_max32(float v) { const auto r = __builtin_amdgcn_permlane32_swap(__float_as_uint(v), __float_as_uint(v), false, false); return fmaxf(__uint_as_float(r[0]), __uint_as_float(r[1])); }
__device__ __forceinline__ float quad_sum(float v) { v += XL_DPP(v, 0xB1); v += XL_DPP(v, 0x4E); return v; }
__device__ __forceinline__ float row_sum(float v) { v = quad_sum(v); v += XL_DPP(v, 0x141); v += XL_DPP(v, 0x128); return v; }
__device__ __forceinline__ float row_max(float v) { v = fmaxf(v, XL_DPP(v, 0xB1)); v = fmaxf(v, XL_DPP(v, 0x4E)); v = fmaxf(v, XL_DPP(v, 0x141)); v = fmaxf(v, XL_DPP(v, 0x128)); return v; }

#define XB_TMO      128
#define XB_XCNT(j)  (256  + 64 * (j))
#define XB_XSUB(j)  (1280 + 64 * (j))
#define XB_XGEN(j)  (2304 + 64 * (j))
#define XB_TOP      3328
#define XB_TOPGEN   3392
#define XCD_BAR_WORDS 3456
#define XB_SPIN_CAP (1u << 24)

__device__ __forceinline__ unsigned xb_ld(unsigned* p)              { return __hip_atomic_load(p, __ATOMIC_RELAXED, __HIP_MEMORY_SCOPE_AGENT); }
__device__ __forceinline__ unsigned xb_add(unsigned* p, unsigned v) { return __hip_atomic_fetch_add(p, v, __ATOMIC_RELAXED, __HIP_MEMORY_SCOPE_AGENT); }
__device__ __forceinline__ unsigned xb_xcc_id() { return (unsigned)__builtin_amdgcn_s_getreg((3 << 11) | 20) & 0xFu; }
#define XB_SPIN(cond, bar) do { unsigned _sp = 0; while (cond) { __builtin_amdgcn_s_sleep(1); \
    if ((++_sp & 255u) == 0u) { if (xb_ld(&(bar)[XB_TMO])) break; if (_sp > XB_SPIN_CAP) { atomicAdd(&(bar)[XB_TMO], 1u); break; } } } } while (0)

struct XcdBarrier {
    unsigned* bar; unsigned x;
    volatile LAS unsigned* st;
};

__device__ __forceinline__ XcdBarrier xcd_barrier_post(unsigned* bar, volatile LAS unsigned* st) {
    XcdBarrier b; b.bar = bar; b.x = xb_xcc_id(); b.st = st;
    if (threadIdx.x == 0) (void)xb_add(&bar[XB_XCNT(b.x)], 1u);
    return b;
}
__device__ __forceinline__ void xcd_barrier_complete(unsigned* bar, unsigned x, unsigned& nloc, unsigned& nx) {
    const unsigned G = gridDim.x * gridDim.y * gridDim.z;
    unsigned sum, cnt, mine, sp = 0u;
    for (;;) {
        sum = 0u; cnt = 0u; mine = 0u;
#pragma unroll
        for (unsigned j = 0; j < 16; ++j) { const unsigned c = xb_ld(&bar[XB_XCNT(j)]); sum += c; cnt += (c > 0u) ? 1u : 0u; mine = (j == x) ? c : mine; }
        if (sum == G) break;
        __builtin_amdgcn_s_sleep(1);
        if ((++sp & 255u) == 0u) { if (xb_ld(&bar[XB_TMO])) break; if (sp > XB_SPIN_CAP) { atomicAdd(&bar[XB_TMO], 1u); break; } }
    }
    nloc = mine > 0u ? mine : 1u; nx = cnt > 0u ? cnt : 1u;
}

__device__ __forceinline__ void xcd_barrier(const XcdBarrier& b) {
    asm volatile("s_waitcnt vmcnt(0)" ::: "memory");
    __syncthreads();
    if (threadIdx.x == 0) {
        unsigned* bar = b.bar;
        __builtin_amdgcn_s_waitcnt(0);
        unsigned nloc = b.st[0], nx = b.st[1];
        if (nloc == 0u) { xcd_barrier_complete(bar, b.x, nloc, nx); b.st[0] = nloc; b.st[1] = nx; }
        const unsigned old = xb_add(&bar[XB_XSUB(b.x)], 1u);
        const unsigned gen = old / nloc;
        if (old + 1u == (gen + 1u) * nloc) {
            __builtin_amdgcn_fence(__ATOMIC_RELEASE, "agent");
            asm volatile("s_waitcnt vmcnt(0)" ::: "memory");
            const unsigned og = xb_add(&bar[XB_TOP], 1u);
            const unsigned tg = og / nx;
            if (og + 1u == (tg + 1u) * nx) xb_add(&bar[XB_TOPGEN], 1u);
            else XB_SPIN(xb_ld(&bar[XB_TOPGEN]) == tg, bar);
            __builtin_amdgcn_fence(__ATOMIC_ACQUIRE, "agent");
            xb_add(&bar[XB_XGEN(b.x)], 1u);
            asm volatile("s_waitcnt vmcnt(0)" ::: "memory");
        } else {
            XB_SPIN(xb_ld(&bar[XB_XGEN(b.x)]) == gen, bar);
            __builtin_amdgcn_fence(__ATOMIC_ACQUIRE, "agent");
            asm volatile("s_waitcnt vmcnt(0)" ::: "memory");
        }
    }
    __syncthreads();
}

struct Args {
    const float* in[19];
    float* out; unsigned char* ws;
    int ph_lo, ph_hi;
};

__device__ const float ROPE_FREQ[32] = {
    1.000000000e+00f, 7.498942018e-01f, 5.623413324e-01f, 4.216965139e-01f, 3.162277639e-01f, 2.371373773e-01f, 1.778279394e-01f, 1.333521456e-01f, 1.000000015e-01f, 7.498942316e-02f, 5.623413250e-02f, 4.216964915e-02f, 3.162277490e-02f, 2.371373773e-02f, 1.778279431e-02f, 1.333521400e-02f, 9.999999776e-03f, 7.498942316e-03f, 5.623413250e-03f, 4.216964822e-03f, 3.162277630e-03f, 2.371373819e-03f, 1.778279431e-03f, 1.333521446e-03f, 1.000000047e-03f, 7.498941850e-04f, 5.623413017e-04f, 4.216965172e-04f, 3.162277571e-04f, 2.371373703e-04f, 1.778279402e-04f, 1.333521504e-04f};
struct Ctx {
    int tid, lane, wave, G, bid;
    LAS unsigned char* lds;
};

__device__ __forceinline__ float wave_sum(float v) { return xl_swap32(xl_swap16(row_sum(v))); }
__device__ __forceinline__ float wave_max(float v) { return xl_max32(xl_max16(row_max(v))); }
__device__ __forceinline__ float gelu_tanh(float x) { const float y = 0.7978845608028654f * (x + 0.044715f * x * x * x); return x * __builtin_amdgcn_rcpf(1.f + __builtin_amdgcn_exp2f(-2.8853900817779268f * y)); }
__device__ __forceinline__ float sigmoid_f(float x) { return __builtin_amdgcn_rcpf(1.f + __builtin_amdgcn_exp2f(-1.4426950408889634f * x)); }
__device__ __forceinline__ int proj_nat(int n) { const int pn = n >> 8, c = n & 255; return 256 * pn + 64 * ((c & 127) >> 5) + 32 * (c >> 7) + (c & 31); }
__device__ __forceinline__ int win_map(int n) {
    if (n < 1280) return proj_nat(n);
    if (n < 2816) return 1304 + (n - 1280);
    if (n < 4864) return 2840 + (n - 2816);
    if (n < 4888) return 1280 + (n - 4864);
    return -1;
}
template <bool MAP, int F8S = 0> __device__ __forceinline__ void p0_transpose_item(const float* W, int K, int N, int NP, bf16* WT, int row_off, LAS float* scr, int item, int lane) {
    const int nblk = NP / 32, kb = item / nblk, nb = item % nblk, k0 = 64 * kb, n0 = 32 * nb;
    int col = n0 + (lane & 31); if (MAP) col = win_map(col);
    float tv[32];
#pragma unroll
    for (int i = 0; i < 32; ++i) { const int kk = 2 * i + (lane >> 5); tv[i] = col >= 0 ? W[(size_t)(k0 + kk) * N + col] : 0.f; }
#pragma unroll
    for (int i = 0; i < 32; ++i) { const int kk = 2 * i + (lane >> 5); scr[kk * 33 + (lane & 31)] = tv[i]; }
    LDS_WAIT(); asm volatile("" ::: "memory");
    const int c = lane & 7;
#pragma unroll
    for (int j = 0; j < 4; ++j) { const int n = (lane >> 3) + 8 * j; const LAS float* s = scr + (8 * c) * 33 + n;
        if constexpr (F8S != 0) { const float sc = (float)F8S; v2u o; o.x = pack4_fp8(s[0 * 33] * sc, s[1 * 33] * sc, s[2 * 33] * sc, s[3 * 33] * sc); o.y = pack4_fp8(s[4 * 33] * sc, s[5 * 33] * sc, s[6 * 33] * sc, s[7 * 33] * sc);
            *(GAS v2u*)((unsigned char*)WT + (size_t)(row_off + n0 + n) * K + k0 + 8 * c) = o; }
        else {
        v4u o; o.x = pk2(s[0 * 33], s[1 * 33]); o.y = pk2(s[2 * 33], s[3 * 33]); o.z = pk2(s[4 * 33], s[5 * 33]); o.w = pk2(s[6 * 33], s[7 * 33]);
        *(GAS v4u*)(WT + (size_t)(row_off + n0 + n) * K + k0 + 8 * c) = o; } }
    LDS_WAIT(); asm volatile("" ::: "memory");
}
template <int NR> __device__ __forceinline__ void rms_rows_to_bf16(const float* x0, size_t xstride, const float* gain, bf16* o0, size_t ostride, int lane, unsigned char* f8 = nullptr) {
    f32x4 v[NR][4]; float s2[NR];
#pragma unroll
    for (int k = 0; k < NR; ++k) { const f32x4* xr = (const f32x4*)(x0 + (size_t)k * xstride) + lane; s2[k] = 0.f;
#pragma unroll
        for (int j = 0; j < 4; ++j) v[k][j] = xr[64 * j]; }
#pragma unroll
    for (int k = 0; k < NR; ++k)
#pragma unroll
        for (int j = 0; j < 4; ++j) s2[k] += (v[k][j].x * v[k][j].x + v[k][j].y * v[k][j].y) + (v[k][j].z * v[k][j].z + v[k][j].w * v[k][j].w);
#pragma unroll
    for (int k = 0; k < NR; ++k) s2[k] = wave_sum(s2[k]);
    const f32x4* gr = (const f32x4*)gain + lane;
#pragma unroll
    for (int k = 0; k < NR; ++k) { const float r = 1.f / sqrtf(s2[k] * (1.f / 1024.f) + EPS); unsigned long long* o8 = (unsigned long long*)(o0 + (size_t)k * ostride) + lane;
#pragma unroll
        for (int j = 0; j < 4; ++j) { const f32x4 g = gr[64 * j];
            o8[64 * j] = (unsigned long long)pk2(v[k][j].x * r * g.x, v[k][j].y * r * g.y) | ((unsigned long long)pk2(v[k][j].z * r * g.z, v[k][j].w * r * g.w) << 32);
            if (f8) ((unsigned*)(f8 + (size_t)k * ostride))[lane + 64 * j] = pack4_fp8(v[k][j].x * r * g.x, v[k][j].y * r * g.y, v[k][j].z * r * g.z, v[k][j].w * r * g.w); } }
}
__device__ __forceinline__ void sincos_d(double a, double& s, double& c) {
    const double kf = rint(a * 0.6366197723675814); const int k = (int)kf;
    double r = fma(-kf, 1.5707963267948966, a); r = fma(-kf, 6.123233995736766e-17, r);
    const double r2 = r * r;
    const double sp = r * (1.0 + r2 * (-1.0 / 6.0 + r2 * (1.0 / 120.0 + r2 * (-1.0 / 5040.0 + r2 * (1.0 / 362880.0 + r2 * (-1.0 / 39916800.0 + r2 * (1.0 / 6227020800.0)))))));
    const double cp = 1.0 + r2 * (-0.5 + r2 * (1.0 / 24.0 + r2 * (-1.0 / 720.0 + r2 * (1.0 / 40320.0 + r2 * (-1.0 / 3628800.0 + r2 * (1.0 / 479001600.0 + r2 * (-1.0 / 87178291200.0)))))));
    const int q = k & 3;
    s = (q == 0) ? sp : (q == 1) ? cp : (q == 2) ? -sp : -cp;
    c = (q == 0) ? cp : (q == 1) ? -sp : (q == 2) ? -cp : sp;
}

__device__ __forceinline__ void p0_prologue(const Args& a, const Ctx& X) {
    LAS float* scr = (LAS float*)(X.lds + RING_OFF + X.wave * 16384);
    const int gw = X.bid * NWAVES + X.wave, NGW = X.G * NWAVES;
    unsigned char* ws = a.ws;
    constexpr int I_IN = 16 * (N1 / 32), I_A = 8 * 32, I_B = 8 * 32, I_O = 16 * 32, I_Q = 16 * 64, I_1 = 32 * 8;
    constexpr int NITEMS = I_IN + I_A + I_B + I_O + I_Q + 2 * I_1;
    for (int it = gw; it < NITEMS; it += NGW) {
        int r = it;
        if (r < I_IN) { if (r % (N1 / 32) >= N_PROJ / 32) p0_transpose_item<true, 32>(a.in[2], 1024, 4888, N1, (bf16*)(ws + WS_WIN8), -N_PROJ, scr, r, X.lane);
            else p0_transpose_item<true>(a.in[2], 1024, 4888, N1, (bf16*)(ws + WS_WIN), 0, scr, r, X.lane); continue; } r -= I_IN;
        if (r < I_A) { p0_transpose_item<false, 32>(a.in[11], 512, 1024, 1024, (bf16*)(ws + WS_WA), 0, scr, r, X.lane); continue; } r -= I_A;
        if (r < I_B) { p0_transpose_item<false, 32>(a.in[12], 512, 1024, 1024, (bf16*)(ws + WS_WA), 1024, scr, r, X.lane); continue; } r -= I_B;
        if (r < I_O) { p0_transpose_item<false, 32>(a.in[13], 1024, 1024, 1024, (bf16*)(ws + WS_WO), 0, scr, r, X.lane); continue; } r -= I_O;
        if (r < I_Q) { p0_transpose_item<false>(a.in[15], 1024, 2048, 2048, (bf16*)(ws + WS_WQ), 0, scr, r, X.lane); continue; } r -= I_Q;
        if (r < I_1) { p0_transpose_item<false>(a.in[7], 2048, 256, 256, (bf16*)(ws + WS_W1), 0, scr, r, X.lane); continue; } r -= I_1;
        p0_transpose_item<false>(a.in[9], 2048, 256, 256, (bf16*)(ws + WS_W1), 256, scr, r, X.lane);
    }
    bf16* XN = (bf16*)a.out;
    if (M_TOK % (8 * NGW) == 0) { for (int m = gw; m < M_TOK; m += 8 * NGW) rms_rows_to_bf16<8>(a.in[0] + (size_t)m * DM, (size_t)NGW * DM, a.in[1], XN + (size_t)m * DM, (size_t)NGW * DM, X.lane, (unsigned char*)a.out + XN8_OFF + (size_t)m * DM); }
    else for (int m = gw; m < M_TOK; m += NGW) rms_rows_to_bf16<1>(a.in[0] + (size_t)m * DM, 0, a.in[1], XN + (size_t)m * DM, 0, X.lane, (unsigned char*)a.out + XN8_OFF + (size_t)m * DM);
    float2* rope = (float2*)(ws + WS_ROPE);
    for (int idx = X.bid * 512 + X.tid; idx < SEQ * 32; idx += X.G * 512) {
        const int pos = idx >> 5, i = idx & 31; const float ang = (float)pos * ROPE_FREQ[i];
        double s, c; sincos_d((double)ang, s, c); rope[idx] = make_float2((float)c, (float)s);
    }
    { bf16* w2t = (bf16*)(ws + WS_W2T); for (int i = X.bid * 512 + X.tid; i < 2 * 64 * 256; i += X.G * 512) { const int kv = i >> 14, d = (i >> 8) & 63, j = i & 255; w2t[i] = (bf16)f2bf((kv ? a.in[10] : a.in[8])[j * 64 + d]); } }
    { bf16* sk16 = (bf16*)(ws + WS_SK16); for (int i = X.bid * 512 + X.tid; i < 2 * 128 * 128; i += X.G * 512) sk16[i] = (bf16)f2bf(a.in[16][i]); }
    for (int it = gw; it < 4 * 512; it += NGW) { const int j = it & 511, q = it >> 9; const float* pe = (j < 256) ? a.in[5] : a.in[6]; const float* w1 = (j < 256) ? a.in[7] : a.in[9]; const int jj = j & 255; float s = 0.f;
#pragma unroll 8
        for (int f = q * 512 + X.lane; f < q * 512 + 512; f += 64) s += pe[f] * w1[(size_t)f * 256 + jj];
        s = wave_sum(s); if (X.lane == 0) ((float*)(ws + WS_BIAS))[q * 512 + j] = s; }
}

__device__ __forceinline__ unsigned gate_u8(float a, float b, float c, float d) {
    unsigned w = __builtin_amdgcn_cvt_pk_u8_f32(__builtin_rintf(a * 255.f), 0, 0u); w = __builtin_amdgcn_cvt_pk_u8_f32(__builtin_rintf(b * 255.f), 1, w); w = __builtin_amdgcn_cvt_pk_u8_f32(__builtin_rintf(c * 255.f), 2, w); return __builtin_amdgcn_cvt_pk_u8_f32(__builtin_rintf(d * 255.f), 3, w); }
struct ProjEpiF { bf16* proj; unsigned char* gate; float* gn;
    __device__ __forceinline__ void operator()(int row, int col, f32x4 v0, f32x4 v1, const pg8::Unit& u) const {
        if (u.pn < 11) { v4u w; w.x = pg8::cvt_pk_bf16(v0[0], v0[1]); w.y = pg8::cvt_pk_bf16(v0[2], v0[3]); w.z = pg8::cvt_pk_bf16(v1[0], v1[1]); w.w = pg8::cvt_pk_bf16(v1[2], v1[3]);
            *(v4u*)(proj + (size_t)row * PJ + col) = w; }
        else if (u.pn < 19) { v2u w;
            w.x = gate_u8(sigmoid_f(v0[0]), sigmoid_f(v0[1]), sigmoid_f(v0[2]), sigmoid_f(v0[3])); w.y = gate_u8(sigmoid_f(v1[0]), sigmoid_f(v1[1]), sigmoid_f(v1[2]), sigmoid_f(v1[3]));
            *(v2u*)(gate + (size_t)row * 2048 + (col - 2816)) = w; }
        else { const int c = col - 4864; if (c < 24) { float* o = gn + (size_t)row * 24 + c;
            *(f32x4*)o = (f32x4){sigmoid_f(v0[0]), sigmoid_f(v0[1]), sigmoid_f(v0[2]), sigmoid_f(v0[3])}; *(f32x4*)(o + 4) = (f32x4){sigmoid_f(v1[0]), sigmoid_f(v1[1]), sigmoid_f(v1[2]), sigmoid_f(v1[3])}; } }
    }
};
struct ProjHeadEpi {
    static constexpr bool PERM = true, AFTER_DRAIN = false;
    bf16* proj; bf16* KC; bf16* VC; const float* qg; const float* kg; const float2* rope;
    __device__ __forceinline__ static v4u pack8(const float (&f)[8]) { v4u w; w.x = pg8::cvt_pk_bf16(f[0], f[1]); w.y = pg8::cvt_pk_bf16(f[2], f[3]); w.z = pg8::cvt_pk_bf16(f[4], f[5]); w.w = pg8::cvt_pk_bf16(f[6], f[7]); return w; }
    __device__ __forceinline__ void operator()(const pg8::f32x4 (&acc)[2][2][4][2], const pg8::Unit& u, int wr, int wc, int fr, int fq) const {
        const int row0 = u.pm * pg8::BM + wr * 64 + fr;
        if (u.pn >= 5) {
            const int col0 = u.pn * pg8::BM + wc * 32 + 8 * fq;
#pragma unroll
            for (int ai = 0; ai < 2; ++ai)
#pragma unroll
                for (int m = 0; m < 4; ++m)
#pragma unroll
                    for (int bj = 0; bj < 2; ++bj) { const f32x4 v0 = acc[ai][bj][m][0], v1 = acc[ai][bj][m][1]; const float f[8] = {v0[0], v0[1], v0[2], v0[3], v1[0], v1[1], v1[2], v1[3]};
                        *(v4u*)(proj + (size_t)(row0 + ai * pg8::HALF + m * 16) * PJ + col0 + bj * pg8::HALF) = pack8(f); }
            return; }
        const int hh = 4 * u.pn + wc;
        const bool isq = hh < 8, iscmp = hh >= 8 && hh < 12, isk = (hh == 12) | (hh == 13) | (hh == 16) | (hh == 17);
        const float* gp = isq ? qg : kg + (hh < 16 ? 64 : 128);
#pragma unroll
        for (int ai = 0; ai < 2; ++ai)
#pragma unroll
            for (int m = 0; m < 4; ++m) { const int row = row0 + ai * pg8::HALF + m * 16;
                const f32x4 a0 = acc[ai][0][m][0], a1 = acc[ai][0][m][1], b0 = acc[ai][1][m][0], b1 = acc[ai][1][m][1];
                float lo[8] = {a0[0], a0[1], a0[2], a0[3], a1[0], a1[1], a1[2], a1[3]}, hi[8] = {b0[0], b0[1], b0[2], b0[3], b1[0], b1[1], b1[2], b1[3]};
                if (iscmp) { const int t = row & (SEQ - 1), b = row >> 13; bf16* dst = ((hh < 10) ? KC : VC) + ((size_t)(b * 2 + (hh & 1)) * SEQ + t) * 64 + 8 * fq;
                    *(v4u*)dst = pack8(lo); *(v4u*)(dst + 32) = pack8(hi); continue; }
                if (isq | isk) { float ss = 0.f;
#pragma unroll
                    for (int j = 0; j < 8; ++j) ss += lo[j] * lo[j] + hi[j] * hi[j];
                    ss = xl_swap32(xl_swap16(ss));
                    const float rs = (1.f / sqrtf(ss * (1.f / 64.f) + EPS)) * (isq ? QSCALE : 1.f);
                    const f32x4 g0 = *(const f32x4*)(gp + 8 * fq), g1 = *(const f32x4*)(gp + 8 * fq + 4), g2 = *(const f32x4*)(gp + 32 + 8 * fq), g3 = *(const f32x4*)(gp + 32 + 8 * fq + 4);
                    const float gl[8] = {g0[0], g0[1], g0[2], g0[3], g1[0], g1[1], g1[2], g1[3]}, gh[8] = {g2[0], g2[1], g2[2], g2[3], g3[0], g3[1], g3[2], g3[3]};
                    const float2* cp = rope + (size_t)(row & (SEQ - 1)) * 32 + 8 * fq;
#pragma unroll
                    for (int j = 0; j < 8; ++j) { const float2 cs = cp[j]; const float yl = lo[j] * rs * gl[j], yh = hi[j] * rs * gh[j]; lo[j] = yl * cs.x - yh * cs.y; hi[j] = yh * cs.x + yl * cs.y; } }
                bf16* dst = proj + (size_t)row * PJ + 64 * hh + 8 * fq; *(v4u*)dst = pack8(lo); *(v4u*)(dst + 32) = pack8(hi); }
    }
};
struct ProjEpiG8 { ProjEpiF f;
    __device__ __forceinline__ void operator()(int row, int col, f32x4 v0, f32x4 v1, const pg8::Unit& u) const { pg8::Unit u2 = u; u2.pn += N_PROJ / 256; f(row, col + N_PROJ, v0 * (1.f / 32.f), v1 * (1.f / 32.f), u2); }
};
struct CmpFusedEpi {
    static constexpr bool PERM = false, AFTER_DRAIN = true;
    const float* bias; const bf16* w2t; const float* kgain; const float2* rope; bf16* kc16; bf16* vc16;
    __device__ __forceinline__ void fused(pg8::f32x4 (&acc)[2][2][4][2], const pg8::Unit& u, int wr, int wc, int fr, int fq, LAS unsigned char* lds, int wid, int lane) const {
        typedef short bf16x8_t __attribute__((ext_vector_type(8)));
        const int colb = u.pn * 256;
#pragma unroll
        for (int ai = 0; ai < 2; ++ai)
#pragma unroll
            for (int m = 0; m < 4; ++m) { const int row = ai * 128 + wr * 64 + m * 16 + fr;
#pragma unroll
                for (int bj = 0; bj < 2; ++bj)
#pragma unroll
                    for (int n = 0; n < 2; ++n) { const int c0 = bj * 128 + wc * 32 + n * 16 + 4 * fq; const f32x4 b4 = (*(const f32x4*)(bias + colb + c0) + *(const f32x4*)(bias + 512 + colb + c0)) + (*(const f32x4*)(bias + 1024 + colb + c0) + *(const f32x4*)(bias + 1536 + colb + c0)); const f32x4 v = acc[ai][bj][m][n] + b4;
                        v2u w; w.x = pg8::cvt_pk_bf16(gelu_tanh(v[0]), gelu_tanh(v[1])); w.y = pg8::cvt_pk_bf16(gelu_tanh(v[2]), gelu_tanh(v[3]));
                        *(LAS v2u*)(lds + row * 512 + (((c0 >> 3) ^ (row & 15)) << 4) + ((c0 >> 2) & 1) * 8) = w; } }
        asm volatile("s_waitcnt lgkmcnt(0)" ::: "memory"); __builtin_amdgcn_s_barrier(); asm volatile("" ::: "memory");
        const int g4 = lane >> 4, cl = lane & 15, kv = u.pn; const bf16* W = w2t + (size_t)kv * 64 * 256;
        f32x4 D[2][4];
#pragma unroll
        for (int rt = 0; rt < 2; ++rt)
#pragma unroll
            for (int dt = 0; dt < 4; ++dt) D[rt][dt] = (f32x4){0.f, 0.f, 0.f, 0.f};
#pragma unroll
        for (int ks = 0; ks < 8; ++ks) { bf16x8_t aa[2], bb[4];
#pragma unroll
            for (int rt = 0; rt < 2; ++rt) aa[rt] = *(const LAS bf16x8_t*)(lds + (32 * wid + 16 * rt + cl) * 512 + (((4 * ks + g4) ^ cl) << 4));
#pragma unroll
            for (int dt = 0; dt < 4; ++dt) bb[dt] = *(const bf16x8_t*)(W + (size_t)(16 * dt + cl) * 256 + 32 * ks + 8 * g4);
#pragma unroll
            for (int rt = 0; rt < 2; ++rt)
#pragma unroll
                for (int dt = 0; dt < 4; ++dt) D[rt][dt] = __builtin_amdgcn_mfma_f32_16x16x32_bf16(aa[rt], bb[dt], D[rt][dt], 0, 0, 0); }
#pragma unroll
        for (int rt = 0; rt < 2; ++rt)
#pragma unroll
            for (int r = 0; r < 4; ++r) { const int row = u.pm * 256 + 32 * wid + 16 * rt + 4 * g4 + r, rr = row & 2047, c = rr & 511;
                float v[4] = {D[rt][0][r], D[rt][1][r], D[rt][2][r], D[rt][3][r]};
                if (kv == 0) { float ss = (v[0] * v[0] + v[1] * v[1]) + (v[2] * v[2] + v[3] * v[3]);
                    ss += __shfl_xor(ss, 1); ss += __shfl_xor(ss, 2); ss += __shfl_xor(ss, 4); ss += __shfl_xor(ss, 8);
                    const float rs = 1.f / sqrtf(ss * (1.f / 64.f) + EPS); float y[4];
#pragma unroll
                    for (int dt = 0; dt < 4; ++dt) y[dt] = v[dt] * rs * kgain[16 * dt + cl];
                    const float2 c0 = rope[(16 * min(c, 510) + 31) * 32 + cl], c1 = rope[(16 * min(c, 510) + 31) * 32 + 16 + cl];
                    v[0] = y[0] * c0.x - y[2] * c0.y; v[1] = y[1] * c1.x - y[3] * c1.y; v[2] = y[2] * c0.x + y[0] * c0.y; v[3] = y[3] * c1.x + y[1] * c1.y; }
                bf16* dst = (kv ? vc16 : kc16) + (size_t)rr * 64 + cl;
#pragma unroll
                for (int dt = 0; dt < 4; ++dt) dst[16 * dt] = (bf16)((c == 511) ? 0u : f2bf(v[dt])); }
    }
};
struct MergeEpiF { const unsigned char* gate; bf16* merged; unsigned char* m8;
    __device__ __forceinline__ void operator()(int row, int col, f32x4 v, const pg8::Unit& u) const {
        v = v * (1.f / 512.f);
        if (u.pm < 64) { const unsigned g = *(const unsigned*)(gate + (size_t)row * 2048 + col); const float g0 = (float)(g & 255u) * (1.f / 255.f), g1 = (float)((g >> 8) & 255u) * (1.f / 255.f), g2 = (float)((g >> 16) & 255u) * (1.f / 255.f), g3 = (float)(g >> 24) * (1.f / 255.f);
            v2u w; w.x = pg8::cvt_pk_bf16(v[0] * g0, v[1] * g1); w.y = pg8::cvt_pk_bf16(v[2] * g2, v[3] * g3); *(v2u*)(merged + (size_t)row * DM + col) = w; }
        else { const int r2 = row - M_TOK, c2 = col - 1024; const unsigned gq = *(const unsigned*)(gate + (size_t)r2 * 2048 + 1024 + c2); const v2u t = *(const v2u*)(merged + (size_t)r2 * DM + c2);
            const float g0 = (float)(gq & 255u) * (1.f / 255.f), g1 = (float)((gq >> 8) & 255u) * (1.f / 255.f), g2 = (float)((gq >> 16) & 255u) * (1.f / 255.f), g3 = (float)(gq >> 24) * (1.f / 255.f);
            *(unsigned*)(m8 + (size_t)r2 * DM + c2) = pack4_fp8(8.f * (bflo(t.x) + v[0] * g0), 8.f * (bfhi(t.x) + v[1] * g1), 8.f * (bflo(t.y) + v[2] * g2), 8.f * (bfhi(t.y) + v[3] * g3)); } }
};
struct MergeOrder { pg8::StaticOrder S0;
    __device__ bool next(int i, pg8::Unit& u) const { if (!S0.next(i >> 1, u)) return false; if (i & 1) { u.pm += 64; u.pn += 4; } return true; }
    __device__ __forceinline__ void a_ready(const pg8::Unit&) const {}
    __device__ __forceinline__ void done(const pg8::Unit&) const {}
};
struct OutNormEpi {
    static constexpr bool PERM = false, AFTER_DRAIN = false;
    const float* x; float* h1; bf16* hb; const float* g2; float* rowss;
    __device__ __forceinline__ void operator()(const pg8::f32x4 (&acc)[2][2][4][2], const pg8::Unit& u, int wr, int wc, int fr, int fq) const {
        const int row0 = u.pm * pg8::BM + wr * 64 + fr, col0 = u.pn * pg8::BM + wc * 32 + 4 * fq;
#pragma unroll
        for (int ai = 0; ai < 2; ++ai)
#pragma unroll
            for (int m = 0; m < 4; ++m) { const int row = row0 + ai * pg8::HALF + m * 16; float ss = 0.f;
#pragma unroll
                for (int bj = 0; bj < 2; ++bj)
#pragma unroll
                    for (int n = 0; n < 2; ++n) { const int col = col0 + bj * pg8::HALF + n * 16; const size_t o = (size_t)row * DM + col;
                        const f32x4 hv = *(const f32x4*)(x + o) + acc[ai][bj][m][n] * (1.f / 256.f);     const f32x4 gv = *(const f32x4*)(g2 + col);
                        v2u w; w.x = pg8::cvt_pk_bf16(hv[0] * gv[0], hv[1] * gv[1]); w.y = pg8::cvt_pk_bf16(hv[2] * gv[2], hv[3] * gv[3]); *(v2u*)(hb + o) = w;
                        ss += (hv[0] * hv[0] + hv[1] * hv[1]) + (hv[2] * hv[2] + hv[3] * hv[3]); }
                ss = xl_swap32(xl_swap16(ss));
                if (fq == 0) rowss[(size_t)row * 16 + u.pn * 4 + wc] = ss; }
    }
};
__device__ __forceinline__ float row_rstd(const float* rowss, int row) { const f32x4* p = (const f32x4*)(rowss + (size_t)row * 16); const f32x4 a = p[0], b = p[1], c = p[2], d = p[3];
    const float s = (((a[0] + a[1]) + (a[2] + a[3])) + ((b[0] + b[1]) + (b[2] + b[3]))) + (((c[0] + c[1]) + (c[2] + c[3])) + ((d[0] + d[1]) + (d[2] + d[3]))); return 1.f / sqrtf(s * (1.f / 1024.f) + EPS); }
struct QpNormEpi {
    static constexpr bool PERM = true, AFTER_DRAIN = false; bf16* qp; const float* rowss;
    __device__ __forceinline__ void operator()(const pg8::f32x4 (&acc)[2][2][4][2], const pg8::Unit& u, int wr, int wc, int fr, int fq) const {
        const int row0 = u.pm * pg8::BM + wr * 64 + fr, col0 = u.pn * pg8::BM + wc * 32 + 8 * fq;
#pragma unroll
        for (int ai = 0; ai < 2; ++ai)
#pragma unroll
            for (int m = 0; m < 4; ++m) { const int row = row0 + ai * pg8::HALF + m * 16; const float rs = row_rstd(rowss, row);
#pragma unroll
                for (int bj = 0; bj < 2; ++bj) { const f32x4 v0 = acc[ai][bj][m][0] * rs, v1 = acc[ai][bj][m][1] * rs;
                    v4u w; w.x = pg8::cvt_pk_bf16(v0[0], v0[1]); w.y = pg8::cvt_pk_bf16(v0[2], v0[3]); w.z = pg8::cvt_pk_bf16(v1[0], v1[1]); w.w = pg8::cvt_pk_bf16(v1[2], v1[3]);
                    *(v4u*)(qp + (size_t)row * 2048 + col0 + bj * pg8::HALF) = w; } }
    }
};

typedef short bf16x8 __attribute__((ext_vector_type(8)));
typedef short s16x4 __attribute__((ext_vector_type(4)));
constexpr int NSA_K0 = 0, NSA_V0 = 32768, NSA_IMP = 65536, NSA_MSK = 98304, NSA_F = 99328, NSA_LDS_END = 99328 + 32768;
__device__ __forceinline__ int swz(int row, int chunk) { return row * 128 + ((chunk ^ ((row >> 1) & 7)) << 4); }
__device__ __forceinline__ s16x4 vtr(const LAS unsigned char* p) { return __builtin_bit_cast(s16x4, __builtin_amdgcn_ds_read_tr16_b64_v4i16((LAS s16x4*)p)); }
__device__ __forceinline__ bf16x8 pack_p(const f32x4& a, const f32x4& b) {
    v4u w; w.x = pg8::cvt_pk_bf16(a[0], a[1]); w.y = pg8::cvt_pk_bf16(a[2], a[3]); w.z = pg8::cvt_pk_bf16(b[0], b[1]); w.w = pg8::cvt_pk_bf16(b[2], b[3]); return __builtin_bit_cast(bf16x8, w); }

struct LaneGeo { int koff0, koff1, voff[4]; };
__device__ __forceinline__ LaneGeo lane_geo(int lane) {
    LaneGeo G; const int r = lane & 15, g4 = lane >> 4;
    G.koff0 = swz(r, g4); G.koff1 = swz(r, 4 + g4);
    const int vr = 4 * g4 + (r >> 2), c0 = (lane & 3) >> 1, hf = lane & 1;
#pragma unroll
    for (int dt = 0; dt < 4; ++dt) G.voff[dt] = swz(vr, 2 * dt + c0) + hf * 8;
    return G;
}
__device__ __forceinline__ void quad_scores(const LAS unsigned char* Kb, const LaneGeo& G, const bf16x8& q0, const bf16x8& q1, float c0, f32x4 (&s)[4]) {
#pragma unroll
    for (int kt = 0; kt < 4; ++kt) {
        const bf16x8 a0 = *(const LAS bf16x8*)(Kb + G.koff0 + kt * 2048), a1 = *(const LAS bf16x8*)(Kb + G.koff1 + kt * 2048);
        s[kt] = __builtin_amdgcn_mfma_f32_16x16x32_bf16(a0, q0, (f32x4){c0, c0, c0, c0}, 0, 0, 0);
        s[kt] = __builtin_amdgcn_mfma_f32_16x16x32_bf16(a1, q1, s[kt], 0, 0, 0);
    }
}
__device__ __forceinline__ void quad_pv(const LAS unsigned char* Vb, const LaneGeo& G, const f32x4 (&p)[4], f32x4 (&o)[4]) {
    const bf16x8 p01 = pack_p(p[0], p[1]), p23 = pack_p(p[2], p[3]);
#pragma unroll
    for (int dt = 0; dt < 4; ++dt) {
        const s16x4 v0 = vtr(Vb + G.voff[dt]), v1 = vtr(Vb + G.voff[dt] + 2048), v2 = vtr(Vb + G.voff[dt] + 4096), v3 = vtr(Vb + G.voff[dt] + 6144);
        const bf16x8 va = (bf16x8){v0[0], v0[1], v0[2], v0[3], v1[0], v1[1], v1[2], v1[3]}, vb = (bf16x8){v2[0], v2[1], v2[2], v2[3], v3[0], v3[1], v3[2], v3[3]};
        o[dt] = __builtin_amdgcn_mfma_f32_16x16x32_bf16(va, p01, o[dt], 0, 0, 0);
        o[dt] = __builtin_amdgcn_mfma_f32_16x16x32_bf16(vb, p23, o[dt], 0, 0, 0);
    }
}
__device__ __forceinline__ void pair_scores(const LAS unsigned char* Kb, const LaneGeo& G, const bf16x8 (&q0)[2], const bf16x8 (&q1)[2], float cA, float cB, f32x4 (&sA)[4], f32x4 (&sB)[4]) {
#pragma unroll
    for (int kt = 0; kt < 4; ++kt) { const bf16x8 a0 = *(const LAS bf16x8*)(Kb + G.koff0 + kt * 2048), a1 = *(const LAS bf16x8*)(Kb + G.koff1 + kt * 2048);
        sA[kt] = __builtin_amdgcn_mfma_f32_16x16x32_bf16(a0, q0[0], (f32x4){cA, cA, cA, cA}, 0, 0, 0);
        sB[kt] = __builtin_amdgcn_mfma_f32_16x16x32_bf16(a0, q0[1], (f32x4){cB, cB, cB, cB}, 0, 0, 0);
        sA[kt] = __builtin_amdgcn_mfma_f32_16x16x32_bf16(a1, q1[0], sA[kt], 0, 0, 0);
        sB[kt] = __builtin_amdgcn_mfma_f32_16x16x32_bf16(a1, q1[1], sB[kt], 0, 0, 0); }
}
__device__ __forceinline__ void pair_pv(const LAS unsigned char* Vb, const LaneGeo& G, const f32x4 (&pA)[4], const f32x4 (&pB)[4], f32x4 (&oA)[4], f32x4 (&oB)[4], f32x4& lA, f32x4& lB) {
    const bf16x8 pA01 = pack_p(pA[0], pA[1]), pA23 = pack_p(pA[2], pA[3]), pB01 = pack_p(pB[0], pB[1]), pB23 = pack_p(pB[2], pB[3]);
    const bf16x8 ones = (bf16x8){0x3F80, 0x3F80, 0x3F80, 0x3F80, 0x3F80, 0x3F80, 0x3F80, 0x3F80};
    lA = __builtin_amdgcn_mfma_f32_16x16x32_bf16(ones, pA01, lA, 0, 0, 0); lB = __builtin_amdgcn_mfma_f32_16x16x32_bf16(ones, pB01, lB, 0, 0, 0);
    lA = __builtin_amdgcn_mfma_f32_16x16x32_bf16(ones, pA23, lA, 0, 0, 0); lB = __builtin_amdgcn_mfma_f32_16x16x32_bf16(ones, pB23, lB, 0, 0, 0);
#pragma unroll
    for (int dt = 0; dt < 4; ++dt) { s16x4 v[4];
#pragma unroll
        for (int kt = 0; kt < 4; ++kt) v[kt] = vtr(Vb + G.voff[dt] + kt * 2048);
        const bf16x8 va = (bf16x8){v[0][0], v[0][1], v[0][2], v[0][3], v[1][0], v[1][1], v[1][2], v[1][3]}, vb = (bf16x8){v[2][0], v[2][1], v[2][2], v[2][3], v[3][0], v[3][1], v[3][2], v[3][3]};
        oA[dt] = __builtin_amdgcn_mfma_f32_16x16x32_bf16(va, pA01, oA[dt], 0, 0, 0);
        oB[dt] = __builtin_amdgcn_mfma_f32_16x16x32_bf16(va, pB01, oB[dt], 0, 0, 0);
        oA[dt] = __builtin_amdgcn_mfma_f32_16x16x32_bf16(vb, pA23, oA[dt], 0, 0, 0);
        oB[dt] = __builtin_amdgcn_mfma_f32_16x16x32_bf16(vb, pB23, oB[dt], 0, 0, 0); }
}
#define LDS_BARRIER() do { asm volatile("s_waitcnt lgkmcnt(0)" ::: "memory"); __builtin_amdgcn_s_barrier(); asm volatile("" ::: "memory"); } while (0)
template <class SrcF, class CompF>
__device__ __forceinline__ void stream_blocks(LAS unsigned char* lds, int nblk, int wave, int lane, SrcF src, CompF comp) {
    const int row = 8 * wave + (lane >> 3), chunk = lane & 7; const int woff = swz(row, chunk);
    __syncthreads();
    if (nblk <= 0) return;
    v4u ka, va, kb, vb; const int last = nblk - 1;
#define SBLK_LD(b_, K_, V_) do { const unsigned char* kp; const unsigned char* vp; int pitch; src(min((b_), last), kp, vp, pitch); K_ = *(const v4u*)(kp + (size_t)row * pitch + chunk * 16); V_ = *(const v4u*)(vp + (size_t)row * pitch + chunk * 16); } while (0)
    SBLK_LD(0, ka, va); SBLK_LD(1, kb, vb);
    for (int b = 0, par = 0; b < nblk; b += 2, par ^= 1) {
        LAS unsigned char* K0 = lds + NSA_K0 + par * 16384; LAS unsigned char* V0 = lds + NSA_V0 + par * 16384;
        *(LAS v4u*)(K0 + woff) = ka; *(LAS v4u*)(V0 + woff) = va; *(LAS v4u*)(K0 + 8192 + woff) = kb; *(LAS v4u*)(V0 + 8192 + woff) = vb;
        LDS_BARRIER();
        SBLK_LD(b + 2, ka, va); SBLK_LD(b + 3, kb, vb);
        comp(b, K0, V0);
        if (b + 1 < nblk) comp(b + 1, K0 + 8192, V0 + 8192);
    }
#undef SBLK_LD
}

__device__ __forceinline__ void nsa_tile(const Args& a, LAS unsigned char* lds, int bg, int qt, int tid, float M2) {
    unsigned char* ws = a.ws; const unsigned char* proj = ws + WS_PROJ;
    const int lane = tid & 63, wave = __builtin_amdgcn_readfirstlane(tid >> 6), g4 = lane >> 4, col = lane & 15, tok = col >> 2, h = col & 3;
    const int b = bg >> 1, g = bg & 1, t0 = qt * 64, cur = qt; const size_t rb = (size_t)b * SEQ;
    const LaneGeo G = lane_geo(lane);
    LAS float* imp = (LAS float*)(lds + NSA_IMP); LAS unsigned* msk = (LAS unsigned*)(lds + NSA_MSK);
    for (int i = tid; i < 64 * 128; i += 512) imp[i] = 0.f;
    bf16x8 q0[2], q1[2]; int tl[2]; LAS bf16* Fl = (LAS bf16*)(lds + NSA_F) + tid;
#pragma unroll
    for (int qd = 0; qd < 2; ++qd) { tl[qd] = 8 * wave + 4 * qd + tok;
        const bf16* qp = (const bf16*)proj + (rb + t0 + tl[qd]) * PJ + (g * 4 + h) * 64 + 8 * g4;
        q0[qd] = *(const bf16x8*)qp; q1[qd] = *(const bf16x8*)(qp + 32); }
    const float* gnp = (const float*)(ws + WS_GN);
    const int nc_max = min(511, (t0 >> 4) + 3), nch = (nc_max + 63) >> 6;
    const unsigned char* kc16 = ws + WS_KC16 + (size_t)bg * 512 * 128; const unsigned char* vc16 = ws + WS_VC16 + (size_t)bg * 512 * 128;
    int ncol[2]; float linv[2];
#pragma unroll
    for (int qd = 0; qd < 2; ++qd) { const int t = t0 + tl[qd]; ncol[qd] = t >= 31 ? ((t - 31) >> 4) + 1 : 0; linv[qd] = 0.f; }
    auto src_c = [&](int bi, const unsigned char*& kp, const unsigned char*& vp, int& pitch) __attribute__((always_inline)) { kp = kc16 + (size_t)bi * 64 * 128; vp = vc16 + (size_t)bi * 64 * 128; pitch = 128; };
    stream_blocks(lds, nch, wave, lane, src_c, [&](int bi, const LAS unsigned char* Kb, const LAS unsigned char* Vb) __attribute__((always_inline)) {
#pragma unroll
        for (int qd = 0; qd < 2; ++qd) { f32x4 s[4]; quad_scores(Kb, G, q0[qd], q1[qd], -M2, s);
#pragma unroll
            for (int kt = 0; kt < 4; ++kt)
#pragma unroll
                for (int r = 0; r < 4; ++r) { const int c = bi * 64 + 16 * kt + 4 * g4 + r; linv[qd] += (c < ncol[qd]) ? __builtin_amdgcn_exp2f(s[kt][r]) : 0.f; } }
    });
#pragma unroll
    for (int qd = 0; qd < 2; ++qd) { float l = linv[qd]; l = xl_swap32(xl_swap16(l)); linv[qd] = l > 0.f ? 1.f / l : 0.f; }
    {
        f32x4 O[2][4];
#pragma unroll
        for (int qd = 0; qd < 2; ++qd)
#pragma unroll
            for (int dt = 0; dt < 4; ++dt) O[qd][dt] = (f32x4){0.f, 0.f, 0.f, 0.f};
        stream_blocks(lds, nch, wave, lane, src_c, [&](int bi, const LAS unsigned char* Kb, const LAS unsigned char* Vb) __attribute__((always_inline)) {
    #pragma unroll
            for (int qd = 0; qd < 2; ++qd) { f32x4 s[4]; quad_scores(Kb, G, q0[qd], q1[qd], -M2, s);
#pragma unroll
                for (int kt = 0; kt < 4; ++kt) {
#pragma unroll
                    for (int r = 0; r < 4; ++r) { const int c = bi * 64 + 16 * kt + 4 * g4 + r; s[kt][r] = (c < ncol[qd]) ? __builtin_amdgcn_exp2f(s[kt][r]) * linv[qd] : 0.f; }
                    float A = s[kt][0] + s[kt][1] + s[kt][2] + 0.5f * s[kt][3], B = 0.5f * s[kt][3];
                    A = quad_sum(A); B = quad_sum(B);
                    const int Gi = bi * 16 + 4 * kt + g4;
                    if (h == 0) { atomicAdd((float*)(imp + tl[qd] * 128 + Gi), A); if (Gi + 1 < 128) atomicAdd((float*)(imp + tl[qd] * 128 + Gi + 1), B); }
                }
                quad_pv(Vb, G, s, O[qd]); }
        });
#pragma unroll
        for (int qd = 0; qd < 2; ++qd) { const float g0 = gnp[(rb + t0 + tl[qd]) * 24 + g * 4 + h];
#pragma unroll
            for (int dt = 0; dt < 4; ++dt)
#pragma unroll
                for (int r = 0; r < 4; ++r) Fl[((qd * 4 + dt) * 4 + r) * 512] = (bf16)f2bf(O[qd][dt][r] * g0); }
    }
    __syncthreads();
#pragma nounroll
    for (int ps = 0; ps < 2; ++ps) { const int tlw = 8 * wave + 4 * (ps & 1) + g4, sub = lane & 15; unsigned m0 = 0u, m1 = 0u, m2 = 0u, m3 = 0u;
        if (cur <= 15) { m0 = (1u << (cur + 1)) - 1u; }
        else { float x[8];
#pragma unroll
            for (int i = 0; i < 8; ++i) { const int j = sub + 16 * i; x[i] = (j >= 1 && j <= cur - 2) ? __uint_as_float((__float_as_uint(imp[tlw * 128 + j]) & ~127u) | (unsigned)(127 - j)) : -3.0e38f; }
#pragma nounroll
            for (int k = 0; k < 13; ++k) { float m = fmaxf(fmaxf(fmaxf(x[0], x[1]), fmaxf(x[2], x[3])), fmaxf(fmaxf(x[4], x[5]), fmaxf(x[6], x[7])));
                m = row_max(m);
                const int bi = 127 - (int)(__float_as_uint(m) & 127u);
                const unsigned bit = 1u << (bi & 31); const int wsel = bi >> 5; m0 |= (wsel == 0) ? bit : 0u; m1 |= (wsel == 1) ? bit : 0u; m2 |= (wsel == 2) ? bit : 0u; m3 |= (wsel == 3) ? bit : 0u;
#pragma unroll
                for (int i = 0; i < 8; ++i) x[i] = (x[i] == m) ? -3.0e38f : x[i]; }
            m0 |= 1u;
#pragma unroll
            for (int f = 0; f < 2; ++f) { const int bi = cur - f; const unsigned bit = 1u << (bi & 31); const int wsel = bi >> 5; m0 |= (wsel == 0) ? bit : 0u; m1 |= (wsel == 1) ? bit : 0u; m2 |= (wsel == 2) ? bit : 0u; m3 |= (wsel == 3) ? bit : 0u; } }
        if (sub == 0) { msk[tlw * 4 + 0] = m0; msk[tlw * 4 + 1] = m1; msk[tlw * 4 + 2] = m2; msk[tlw * 4 + 3] = m3;
        } }
    __syncthreads();
    LAS unsigned char* qpark = lds + NSA_IMP + tid * 16;
    *(LAS bf16x8*)(qpark) = q0[0]; *(LAS bf16x8*)(qpark + 8192) = q1[0]; *(LAS bf16x8*)(qpark + 16384) = q0[1]; *(LAS bf16x8*)(qpark + 24576) = q1[1];
    {
        f32x4 O[2][4]; f32x4 lacc[2];
#pragma unroll
        for (int qd = 0; qd < 2; ++qd) { lacc[qd] = (f32x4){0.f, 0.f, 0.f, 0.f};
#pragma unroll
            for (int dt = 0; dt < 4; ++dt) O[qd][dt] = (f32x4){0.f, 0.f, 0.f, 0.f}; }
        const unsigned char* ksb = proj + (rb * PJ + C_KV + 2 * 128 + g * 64) * 2; const unsigned char* vsb = proj + (rb * PJ + C_KV + 3 * 128 + g * 64) * 2;
        stream_blocks(lds, cur + 1, wave, lane,
            [&](int j, const unsigned char*& kp, const unsigned char*& vp, int& pitch) __attribute__((always_inline)) { kp = ksb + (size_t)j * 64 * PJ * 2; vp = vsb + (size_t)j * 64 * PJ * 2; pitch = PJ * 2; },
            [&](int j, const LAS unsigned char* Kb, const LAS unsigned char* Vb) __attribute__((always_inline)) {
                const bool selA = (msk[tl[0] * 4 + (j >> 5)] >> (j & 31)) & 1u, selB = (msk[tl[1] * 4 + (j >> 5)] >> (j & 31)) & 1u;
                if (__ballot(selA || selB) != 0ull) { f32x4 sA[4], sB[4];
                    const bf16x8 qa[2] = {*(const LAS bf16x8*)(qpark), *(const LAS bf16x8*)(qpark + 16384)}, qb[2] = {*(const LAS bf16x8*)(qpark + 8192), *(const LAS bf16x8*)(qpark + 24576)};
                    pair_scores(Kb, G, qa, qb, selA ? -M2 : -1.0e30f, selB ? -M2 : -1.0e30f, sA, sB);
                    if (j < cur) {
#pragma unroll
                        for (int kt = 0; kt < 4; ++kt)
#pragma unroll
                            for (int r = 0; r < 4; ++r) { const float eA = __builtin_amdgcn_exp2f(sA[kt][r]), eB = __builtin_amdgcn_exp2f(sB[kt][r]); sA[kt][r] = eA; sB[kt][r] = eB; }
                    } else {
#pragma unroll
                        for (int kt = 0; kt < 4; ++kt)
#pragma unroll
                            for (int r = 0; r < 4; ++r) { const int key = 16 * kt + 4 * g4 + r; const float eA = (key <= tl[0]) ? __builtin_amdgcn_exp2f(sA[kt][r]) : 0.f, eB = (key <= tl[1]) ? __builtin_amdgcn_exp2f(sB[kt][r]) : 0.f;
                                sA[kt][r] = eA; sB[kt][r] = eB; }
                    }
                    pair_pv(Vb, G, sA, sB, O[0], O[1], lacc[0], lacc[1]); }
            });
#pragma unroll
        for (int qd = 0; qd < 2; ++qd) { const float ls = lacc[qd][0]; const float sc = gnp[(rb + t0 + tl[qd]) * 24 + 8 + g * 4 + h] / ls;
#pragma unroll
            for (int dt = 0; dt < 4; ++dt)
#pragma unroll
                for (int r = 0; r < 4; ++r) Fl[((qd * 4 + dt) * 4 + r) * 512] = (bf16)f2bf(bf2f(Fl[((qd * 4 + dt) * 4 + r) * 512]) + O[qd][dt][r] * sc); }
    }
    {
        f32x4 O[2][4]; f32x4 lacc[2];
#pragma unroll
        for (int qd = 0; qd < 2; ++qd) { lacc[qd] = (f32x4){0.f, 0.f, 0.f, 0.f};
#pragma unroll
            for (int dt = 0; dt < 4; ++dt) O[qd][dt] = (f32x4){0.f, 0.f, 0.f, 0.f}; }
        const int i0 = (cur >= 8) ? 0 : 8 - cur;
        const unsigned char* kwb = proj + (rb * PJ + C_KV + 4 * 128 + g * 64) * 2; const unsigned char* vwb = proj + (rb * PJ + C_KV + 5 * 128 + g * 64) * 2;
        stream_blocks(lds, 9 - i0, wave, lane,
            [&](int bi, const unsigned char*& kp, const unsigned char*& vp, int& pitch) __attribute__((always_inline)) { const int p0 = t0 - 512 + 64 * (bi + i0); kp = kwb + (size_t)p0 * PJ * 2; vp = vwb + (size_t)p0 * PJ * 2; pitch = PJ * 2; },
            [&](int bi, const LAS unsigned char* Kb, const LAS unsigned char* Vb) __attribute__((always_inline)) { const int i = bi + i0;
                f32x4 sA[4], sB[4];
                const bf16x8 qa[2] = {*(const LAS bf16x8*)(qpark), *(const LAS bf16x8*)(qpark + 16384)}, qb[2] = {*(const LAS bf16x8*)(qpark + 8192), *(const LAS bf16x8*)(qpark + 24576)};
                pair_scores(Kb, G, qa, qb, -M2, -M2, sA, sB);
                if (i != 0 && i != 8) {
#pragma unroll
                    for (int kt = 0; kt < 4; ++kt)
#pragma unroll
                        for (int r = 0; r < 4; ++r) { const float eA = __builtin_amdgcn_exp2f(sA[kt][r]), eB = __builtin_amdgcn_exp2f(sB[kt][r]); sA[kt][r] = eA; sB[kt][r] = eB; }
                } else {
#pragma unroll
                    for (int kt = 0; kt < 4; ++kt)
#pragma unroll
                        for (int r = 0; r < 4; ++r) { const int key = 16 * kt + 4 * g4 + r; const bool okA = (i == 0) ? (key > tl[0]) : (key <= tl[0]), okB = (i == 0) ? (key > tl[1]) : (key <= tl[1]);
                            const float eA = okA ? __builtin_amdgcn_exp2f(sA[kt][r]) : 0.f, eB = okB ? __builtin_amdgcn_exp2f(sB[kt][r]) : 0.f; sA[kt][r] = eA; sB[kt][r] = eB; }
                }
                pair_pv(Vb, G, sA, sB, O[0], O[1], lacc[0], lacc[1]);
            });
        bf16* onsa = (bf16*)(ws + WS_ONSA);
#pragma unroll
        for (int qd = 0; qd < 2; ++qd) { const float ls = lacc[qd][0]; const float sc = gnp[(rb + t0 + tl[qd]) * 24 + 16 + g * 4 + h] / ls;
#pragma unroll
            for (int dt = 0; dt < 4; ++dt) { float f[4];
#pragma unroll
                for (int r = 0; r < 4; ++r) f[r] = bf2f(Fl[((qd * 4 + dt) * 4 + r) * 512]) + O[qd][dt][r] * sc;
                *(unsigned*)((unsigned char*)onsa + (size_t)(rb + t0 + tl[qd]) * 512 + (g * 4 + h) * 64 + 4 * g4 + 16 * dt) = pack4_fp8(16.f * f[0], 16.f * f[1], 16.f * f[2], 16.f * f[3]); } }
    }
    __syncthreads();
}

__device__ __forceinline__ float exp_fast(float x) { return __builtin_amdgcn_exp2f(x * 1.4426950408889634f); }
__device__ __forceinline__ float softplus_fast(float z) { return fmaxf(z, 0.f) + 0.6931471805599453f * __builtin_amdgcn_logf(1.f + __builtin_amdgcn_exp2f(-fabsf(z) * 1.4426950408889634f)); }
__device__ __forceinline__ void sb_tile(const Args& a, LAS unsigned char* lds, int bh, int tile, int tid) {
    unsigned char* ws = a.ws; const unsigned char* proj = ws + WS_PROJ;
    const int lane = tid & 63, wave = __builtin_amdgcn_readfirstlane(tid >> 6), g4 = lane >> 4, col = lane & 15;
    const int b = bh >> 3, hh = bh & 7, t0 = tile * 128, tw0 = t0 + 16 * wave, t = tw0 + col; const size_t rb = (size_t)b * SEQ;
    const LaneGeo G = lane_geo(lane);
    const bf16* qp = (const bf16*)proj + (rb + t) * PJ + C_SB + hh * 64 + 8 * g4;
    const bf16x8 q0 = *(const bf16x8*)qp, q1 = *(const bf16x8*)(qp + 32);
    f32x4 o[4];
#pragma unroll
    for (int dt = 0; dt < 4; ++dt) o[dt] = (f32x4){0.f, 0.f, 0.f, 0.f};
    float carry = 0.f;
    const unsigned char* kbase = proj + (rb * PJ + C_SB + 512 + hh * 64) * 2; const unsigned char* vbase = proj + (rb * PJ + C_SB + 1024 + hh * 64) * 2;
    const int row = 8 * wave + (lane >> 3), chunk = lane & 7; const int woff = swz(row, chunk);
    int kb = (t0 >> 6) + 1;
    __syncthreads();
    v4u kr0, vr0, kr1, vr1;
#define SBT_LD(kb_, K_, V_) do { const size_t off = ((size_t)(kb_) * 64 + row) * (PJ * 2) + chunk * 16; K_ = *(const v4u*)(kbase + off); V_ = *(const v4u*)(vbase + off); } while (0)
#define SBT_STEP(par_, K_, V_) { LAS unsigned char* Kb = lds + NSA_K0 + (par_) * 8192; LAS unsigned char* Vb = lds + NSA_V0 + (par_) * 8192; \
        *(LAS v4u*)(Kb + woff) = K_; *(LAS v4u*)(Vb + woff) = V_; \
        __syncthreads(); \
        if (kb > 1) SBT_LD(kb - 2, K_, V_); \
        bool pending = true; \
        if (64 * kb <= tw0 + 14) { \
            f32x4 s[4]; quad_scores(Kb, G, q0, q1, 0.f, s); \
            _Pragma("unroll") for (int kt = 3; kt >= 0; --kt) { \
                float sp[4], z[4]; \
                _Pragma("unroll") for (int r = 0; r < 4; ++r) { const int key = 64 * kb + 16 * kt + 4 * g4 + r; z[r] = s[kt][r] * 0.125f; sp[r] = (key < t) ? softplus_fast(z[r]) : 0.f; } \
                const float g = (sp[0] + sp[1]) + (sp[2] + sp[3]); \
                  \
                const auto r16_ = __builtin_amdgcn_permlane16_swap(__float_as_uint(g), __float_as_uint(g), false, false); const float s16 = __uint_as_float(r16_[0]) + __uint_as_float(r16_[1]); \
                const auto r32_ = __builtin_amdgcn_permlane32_swap(__float_as_uint(s16), __float_as_uint(s16), false, false); const float tot = __uint_as_float(r32_[0]) + __uint_as_float(r32_[1]); \
                const float above = (g4 == 0) ? (tot - g) : (g4 == 1) ? (tot - s16) : (g4 == 2) ? (s16 - g) : 0.f; \
                const float c3 = carry + above + sp[3], c2 = c3 + sp[2], c1 = c2 + sp[1], c0 = c1 + sp[0]; \
                const int key0 = 64 * kb + 16 * kt + 4 * g4; \
                s[kt][3] = (key0 + 3 < t) ? exp_fast(z[3] - c3) : 0.f; s[kt][2] = (key0 + 2 < t) ? exp_fast(z[2] - c2) : 0.f; \
                s[kt][1] = (key0 + 1 < t) ? exp_fast(z[1] - c1) : 0.f; s[kt][0] = (key0 < t) ? exp_fast(z[0] - c0) : 0.f; \
                carry += tot; } \
            quad_pv(Vb, G, s, o); \
            pending = !__all(carry > 80.f); } \
        if (kb == 0) break; \
        --kb; \
        if (!__syncthreads_or(pending ? 1 : 0)) break; }
    SBT_LD(kb, kr0, vr0); if (kb > 0) SBT_LD(kb - 1, kr1, vr1);
    for (;;) {
        SBT_STEP(0, kr0, vr0)
        SBT_STEP(1, kr1, vr1)
    }
#undef SBT_LD
#undef SBT_STEP
#pragma unroll
    for (int dt = 0; dt < 4; ++dt) *(unsigned*)(ws + WS_ONSA + (size_t)M_TOK * 512 + (size_t)(rb + t) * 512 + hh * 64 + 4 * g4 + 16 * dt) = pack4_fp8(16.f * o[dt][0], 16.f * o[dt][1], 16.f * o[dt][2], 16.f * o[dt][3]);
    __syncthreads();
}

typedef long i64_t;
constexpr int PE_EX = 0, PE_GW = 8192, PE_AW = 16384, PE_WAVE = 24576, PE_WAVE_BYTES = 3072, PE_SK = 49152, PE_SK_ROW = 272, PE_HF = 118784, PE_HZ = 135168;
__device__ const unsigned char PAIR_TAB[52] = {
    0x00,0x01,0x02,0x03,0x04,0x05,0x06,0x07,0x08,0x09,0x0a,0x0b,0x0c,0x0d,0x0e,0x0f,
    0x10,0x11,0x12,0x13,0x14,0x15,0x16,0x17,
    0x20,0x21,0x22,0x23,0x24,
    0x30,0x31,0x32,0x33,
    0x40,0x41,0x42,
    0x50,0x51,
    0x60,0x61,
    0x70,0x71,
    0x80,0x90,0xa0,0xb0,0xc0,0xd0,0xe0,0xf0,
    0xff,0xff};
typedef float f32x2v __attribute__((ext_vector_type(2)));
__device__ __forceinline__ unsigned pack4_i8(float x0, float x1, float x2, float x3) { return ((unsigned)(__float2int_rn(x0) & 255)) | ((unsigned)(__float2int_rn(x1) & 255) << 8) | ((unsigned)(__float2int_rn(x2) & 255) << 16) | ((unsigned)(__float2int_rn(x3) & 255) << 24); }
template <int NR, int MODE> __device__ __forceinline__ void quant_rows(const float* s0, size_t sstride, unsigned char* d0, size_t dstride, float* sc0, int scstride, int lane) {
    f32x4 x[NR][4]; float am[NR];
#pragma unroll
    for (int k = 0; k < NR; ++k) { const f32x4* s4 = (const f32x4*)(s0 + (size_t)k * sstride) + lane; am[k] = 0.f;
#pragma unroll
        for (int j = 0; j < 4; ++j) x[k][j] = s4[64 * j]; }
#pragma unroll
    for (int k = 0; k < NR; ++k)
#pragma unroll
        for (int j = 0; j < 4; ++j) am[k] = fmaxf(am[k], fmaxf(fmaxf(fabsf(x[k][j][0]), fabsf(x[k][j][1])), fmaxf(fabsf(x[k][j][2]), fabsf(x[k][j][3]))));
#pragma unroll
    for (int k = 0; k < NR; ++k) am[k] = wave_max(am[k]);
#pragma unroll
    for (int k = 0; k < NR; ++k) { const float sc = am[k] > 0.f ? am[k] * (MODE ? (1.f / 127.f) : (1.f / 440.f)) : 1.f; const float inv = 1.f / sc; unsigned* d4 = (unsigned*)(d0 + (size_t)k * dstride) + lane;
#pragma unroll
        for (int j = 0; j < 4; ++j) d4[64 * j] = MODE ? pack4_i8(x[k][j][0] * inv, x[k][j][1] * inv, x[k][j][2] * inv, x[k][j][3] * inv) : pack4_fp8(x[k][j][0] * inv, x[k][j][1] * inv, x[k][j][2] * inv, x[k][j][3] * inv);
        if (lane == 0) sc0[(size_t)k * scstride] = sc; }
}
__device__ __forceinline__ void ce_desc(float& a, float& b) { const float hi = fmaxf(a, b), lo = fminf(a, b); a = hi; b = lo; }
template <int N> __device__ __forceinline__ void bitonic_sort_desc(float (&x)[N]) {
#pragma unroll
    for (int k = 2; k <= N; k <<= 1)
#pragma unroll
        for (int j = k >> 1; j > 0; j >>= 1)
#pragma unroll
            for (int i = 0; i < N; ++i) { const int l = i ^ j; if (l > i) { if ((i & k) == 0) ce_desc(x[i], x[l]); else ce_desc(x[l], x[i]); } }
}
__device__ __forceinline__ void merge_top16(float (&x)[16], int mask) {
    float r[16];
#pragma unroll
    for (int i = 0; i < 16; ++i) r[i] = __shfl_xor(x[15 - i], mask);
#pragma unroll
    for (int i = 0; i < 16; ++i) x[i] = fmaxf(x[i], r[i]);
#pragma unroll
    for (int j = 8; j > 0; j >>= 1)
#pragma unroll
        for (int i = 0; i < 16; ++i) { const int l = i ^ j; if (l > i) ce_desc(x[i], x[l]); }
}

__device__ __forceinline__ void quant_step(const Args& a, int gw, int NGW, int s, int lane) {
    unsigned char* ws = a.ws; const int r = gw + 4 * (s & 1) * NGW;
    if (r + 3 * NGW >= 16384) return;
    if (s < 2) quant_rows<4, 1>(a.in[17] + (size_t)r * DM, (size_t)NGW * DM, ws + WS_U8 + (size_t)r * 1024, (size_t)NGW * 1024, (float*)(ws + WS_SU) + r, NGW, lane);
    else quant_rows<4, 0>(a.in[18] + (size_t)r * DM, (size_t)NGW * DM, ws + WS_V8 + (size_t)r * 1024, (size_t)NGW * 1024, (float*)(ws + WS_SVS) + r, NGW, lane);
}
__device__ __forceinline__ void p5_mixers(const Args& a, const Ctx& X) {
    float* sm = (float*)((unsigned char*)X.lds);
    float M2;
    { const float gq = wave_max(fabsf(a.in[3][X.lane])); const float gk = wave_max(fmaxf(fmaxf(fabsf(a.in[4][X.lane]), fabsf(a.in[4][64 + X.lane])), fabsf(a.in[4][128 + X.lane])));
      M2 = 8.2f * gq * gk * 1.4426950408889634f; }
    const int gwq = X.bid * NWAVES + X.wave, NGWq = X.G * NWAVES; int qs = 0;
    for (int it = X.bid; it < 512; it += X.G) { const int r = it >> 8, idx = it & 255, bg = idx >> 6, qh = idx & 63;
        if (qs < 4) quant_step(a, gwq, NGWq, qs++, X.lane);
        nsa_tile(a, X.lds, bg, r == 0 ? 127 - qh : qh, X.tid, M2);
        if (qs < 4) quant_step(a, gwq, NGWq, qs++, X.lane); }
    if (8 * NGWq != 16384) {
        for (int r = gwq; r < 16384; r += NGWq) quant_rows<1, 1>(a.in[17] + (size_t)r * DM, 0, a.ws + WS_U8 + (size_t)r * 1024, 0, (float*)(a.ws + WS_SU) + r, 0, X.lane);
        for (int r = gwq; r < 16384; r += NGWq) quant_rows<1, 0>(a.in[18] + (size_t)r * DM, 0, a.ws + WS_V8 + (size_t)r * 1024, 0, (float*)(a.ws + WS_SVS) + r, 0, X.lane); }
    else while (qs < 4) quant_step(a, gwq, NGWq, qs++, X.lane);
}
__device__ __forceinline__ void p3_sb(const Args& a, const Ctx& X, int first, int stride) {
    for (int it = first; it < 1024; it += stride) { const int r = it >> 8, idx = it & 255, bh = idx >> 4, th = idx & 15; sb_tile(a, X.lds, bh, r * 16 + th, X.tid); }
}

__device__ __forceinline__ void peer_route16(const Args& a, LAS unsigned char* lds, int m0, int hd, int lane) {
    unsigned char* ws = a.ws; const int col = lane & 15, g4 = lane >> 4;
    LAS float* svL = (LAS float*)(lds + PE_WAVE + hd * PE_WAVE_BYTES); LAS float* cvL = svL + 512;
    const bf16* qp = (const bf16*)(ws + WS_QP) + (size_t)(m0 + col) * 2048 + hd * 256 + 8 * g4; const LAS unsigned char* skL = lds + PE_SK + col * PE_SK_ROW + 16 * g4;
#pragma unroll
    for (int p = 0; p < 2; ++p) {
        f32x4 acc[8];
#pragma unroll
        for (int kt = 0; kt < 8; ++kt) acc[kt] = (f32x4){0.f, 0.f, 0.f, 0.f};
#pragma unroll
        for (int ks = 0; ks < 4; ++ks) { const bf16x8 bq = *(const bf16x8*)(qp + p * 128 + 32 * ks);
#pragma unroll
            for (int kt = 0; kt < 8; ++kt) { const bf16x8 ak = *(const LAS bf16x8*)(skL + (p * 128 + 16 * kt) * PE_SK_ROW + 64 * ks);
                acc[kt] = __builtin_amdgcn_mfma_f32_16x16x32_bf16(ak, bq, acc[kt], 0, 0, 0); } }
        float x[32];
#pragma unroll
        for (int kt = 0; kt < 8; ++kt)
#pragma unroll
            for (int r = 0; r < 4; ++r) { const float av = acc[kt][r]; x[kt * 4 + r] = __uint_as_float((__float_as_uint(av) & ~127u) | (unsigned)(16 * kt + 4 * g4 + r)); }
        bitonic_sort_desc<32>(x);
        float t16[16];
#pragma unroll
        for (int i = 0; i < 16; ++i) t16[i] = x[i];
        merge_top16(t16, 16); merge_top16(t16, 32);
        if (g4 == 0) { LAS f32x4* dstv = (LAS f32x4*)(svL + (p * 16 + col) * 16);
#pragma unroll
            for (int i = 0; i < 4; ++i) dstv[i] = (f32x4){t16[4 * i], t16[4 * i + 1], t16[4 * i + 2], t16[4 * i + 3]}; }
    }
    __builtin_amdgcn_fence(__ATOMIC_RELEASE, "wavefront"); __builtin_amdgcn_wave_barrier(); __builtin_amdgcn_fence(__ATOMIC_ACQUIRE, "wavefront");
    float c[16];
#pragma unroll
    for (int i = 0; i < 16; ++i) { const int ci = g4 + 4 * i; const unsigned ab = PAIR_TAB[min(ci, 51)];
        const float s0 = __uint_as_float(__float_as_uint(svL[(0 * 16 + col) * 16 + (ab >> 4 & 15)]) & ~127u), s1 = __uint_as_float(__float_as_uint(svL[(1 * 16 + col) * 16 + (ab & 15)]) & ~127u);
        c[i] = (ci < 50) ? __uint_as_float((__float_as_uint(s0 + s1) & ~63u) | (unsigned)(63 - ci)) : -3.0e38f; }
    bitonic_sort_desc<16>(c); merge_top16(c, 16); merge_top16(c, 32);
    if (g4 == 0) { LAS f32x4* dstv = (LAS f32x4*)(cvL + col * 16);
#pragma unroll
        for (int i = 0; i < 4; ++i) dstv[i] = (f32x4){c[4 * i], c[4 * i + 1], c[4 * i + 2], c[4 * i + 3]}; }
    __builtin_amdgcn_fence(__ATOMIC_RELEASE, "wavefront"); __builtin_amdgcn_wave_barrier(); __builtin_amdgcn_fence(__ATOMIC_ACQUIRE, "wavefront");
    const float mx = __builtin_bit_cast(float, __builtin_bit_cast(unsigned, cvL[col * 16]) & ~63u);
    float ev[4]; int ee[4]; float ssum = 0.f;
#pragma unroll
    for (int i = 0; i < 4; ++i) { const unsigned cb = __builtin_bit_cast(unsigned, cvL[col * 16 + 4 * g4 + i]); const int ci = 63 - (int)(cb & 63u); const unsigned ab = PAIR_TAB[ci];
        const int i1 = (int)(__builtin_bit_cast(unsigned, svL[(0 * 16 + col) * 16 + (ab >> 4 & 15)]) & 127u), i2 = (int)(__builtin_bit_cast(unsigned, svL[(1 * 16 + col) * 16 + (ab & 15)]) & 127u);
        ee[i] = i1 * 128 + i2; ev[i] = expf(__builtin_bit_cast(float, cb & ~63u) - mx); ssum += ev[i]; }
    ssum = xl_swap32(xl_swap16(ssum)); const float inv = 1.f / ssum;
    LAS int* exL = (LAS int*)(lds + PE_EX); LAS float* gwL = (LAS float*)(lds + PE_GW);
#pragma unroll
    for (int i = 0; i < 4; ++i) { exL[col * 128 + hd * 16 + 4 * g4 + i] = ee[i]; gwL[col * 128 + hd * 16 + 4 * g4 + i] = ev[i] * inv; }
}

__device__ __forceinline__ void peer_emit1(const Args& a, LAS unsigned char* lds, int m, int tk, int lane) {
    unsigned char* ws = a.ws; const int col = lane & 15, g4 = lane >> 4;
    const LAS int* exL = (const LAS int*)(lds + PE_EX) + tk * 128; const LAS float* gwL = (const LAS float*)(lds + PE_GW) + tk * 128;
    {
      const v4u* hr = (const v4u*)((const bf16*)(ws + WS_HN) + (size_t)m * DM + 16 * lane); const v4u w0 = hr[0], w1 = hr[1];
      float f[16] = {bflo(w0.x), bfhi(w0.x), bflo(w0.y), bfhi(w0.y), bflo(w0.z), bfhi(w0.z), bflo(w0.w), bfhi(w0.w), bflo(w1.x), bfhi(w1.x), bflo(w1.y), bfhi(w1.y), bflo(w1.z), bfhi(w1.z), bflo(w1.w), bfhi(w1.w)};
      const float rs_ = row_rstd((const float*)(ws + WS_ROWSS), m);
      float am = 0.f;
#pragma unroll
      for (int i = 0; i < 16; ++i) { f[i] *= rs_; am = fmaxf(am, fabsf(f[i])); }
      am = wave_max(am); const float sh = am > 0.f ? am * (1.f / 127.f) : 1.f; const float inv = 1.f / sh;
      v4u qh; qh.x = pack4_i8(f[0] * inv, f[1] * inv, f[2] * inv, f[3] * inv); qh.y = pack4_i8(f[4] * inv, f[5] * inv, f[6] * inv, f[7] * inv); qh.z = pack4_i8(f[8] * inv, f[9] * inv, f[10] * inv, f[11] * inv); qh.w = pack4_i8(f[12] * inv, f[13] * inv, f[14] * inv, f[15] * inv);
      *(v4u*)(ws + WS_HF8 + (size_t)m * 1024 + 16 * lane) = qh;
      if (lane == 0) ((float*)(ws + WS_SH))[m] = sh; }
    const int e0 = exL[lane], e1 = exL[lane + 64]; const int hh0 = ((e0 >> 7) + e0) & 15, hh1 = ((e1 >> 7) + e1) & 15; const int r0 = ((hh0 & 7) << 1) | (hh0 >> 3), r1 = ((hh1 & 7) << 1) | (hh1 >> 3);       const unsigned long long lt = (1ull << lane) - 1ull;
    int base = 0, pos0 = 0, pos1 = 0, myoff = 0;
#pragma unroll
    for (int rr = 0; rr < 16; ++rr) { const unsigned long long b0 = __ballot(r0 == rr), b1 = __ballot(r1 == rr); const int c0 = __popcll(b0), c1 = __popcll(b1);
        if (r0 == rr) pos0 = base + __popcll(b0 & lt); if (r1 == rr) pos1 = base + c0 + __popcll(b1 & lt);
        if (lane == rr) myoff = base; base += c0 + c1; }
    if (lane == 16) myoff = 128;
    { const int myn = __shfl_down(myoff, 2) - myoff;
      if (lane < 16 && !(lane & 1) && myn > 8 * HU_MAX) { const unsigned slot = __hip_atomic_fetch_add((gu32*)(ws + WS_CTL) + CW_NEXC, 1u, RLX_AGENT); if (slot < (unsigned)EXC_CAP) __hip_atomic_store((gu32*)(ws + WS_CTL) + CW_EXC + slot, ((unsigned)m << 4) | (unsigned)(lane >> 1), RLX_AGENT); } }
    unsigned* plr = (unsigned*)(ws + WS_PLR) + (size_t)m * 128;
    plr[pos0] = ((unsigned)e0 << 16) | f2bf(gwL[lane]); plr[pos1] = ((unsigned)e1 << 16) | f2bf(gwL[lane + 64]);
    if (lane < 32) (ws + WS_OFF)[(size_t)m * 32 + lane] = (unsigned char)myoff;
}
struct PhSet { v4u W[8]; v4u h0; float su, sv, sh; unsigned pw, pwn; };
__device__ __forceinline__ void peer_u_pass2(const Args& a, LAS unsigned char* lds, int wave, int first, int stride, int R, int rr0, int gbase, int lane) {
    unsigned char* ws = a.ws; const unsigned char* U8 = ws + WS_U8; const float* SU = (const float*)(ws + WS_SU); const float* SV = (const float*)(ws + WS_SVS); const unsigned* PLR = (const unsigned*)(ws + WS_PLR);
    unsigned* dump = (unsigned*)(ws + WS_CTL + 65536) + (size_t)(blockIdx.x * NWAVES + wave) * 64 + lane;
    if (first >= M_TOK) return;
    const int nunits = ((M_TOK - 1 - first) / stride + 1) * R;
    LAS unsigned* L = (LAS unsigned*)(lds + wave * 4096);
    int cnt = 0;
    for (int u0 = 0; u0 < nunits; u0 += 64) { const int u = u0 + lane; const bool ok = u < nunits; const int uc = ok ? u : 0;
        const int m = first + (uc / R) * stride, rr = rr0 + 8 * (uc % R); const unsigned char* offp = ws + WS_OFF + (size_t)m * 32; const int off = offp[rr], n = (int)offp[rr + 2] - off;
        const int nh = ok ? min(max((n - gbase + 7) >> 3, 1), HU_MAX) : 0;
        int pre = nh;
#pragma unroll
        for (int o = 1; o < 64; o <<= 1) { const int y = __shfl_up(pre, o); if (lane >= o) pre += y; }
        const int pos = cnt + pre - nh;
#pragma unroll
        for (int i = 0; i < 4; ++i) if (i < nh && pos + i < 510) { L[2 * (pos + i)] = (unsigned)m | ((unsigned)rr << 16) | ((unsigned)i << 24); L[2 * (pos + i) + 1] = (unsigned)off | ((unsigned)n << 8); }
        cnt += __shfl(pre, 63); }
    cnt = __builtin_amdgcn_readfirstlane(min(cnt, 510));
    __builtin_amdgcn_fence(__ATOMIC_RELEASE, "wavefront"); __builtin_amdgcn_wave_barrier(); __builtin_amdgcn_fence(__ATOMIC_ACQUIRE, "wavefront");
    const bool b0_ = lane & 1, b1_ = lane & 2, b2_ = lane & 4; const int myrow_ = 4 * (int)b0_ + 2 * (int)b1_ + (int)b2_; const unsigned lane16 = 16u * (unsigned)lane;
#define PH_ENT(k_, m_, off_, n_, hf_) do { const int kc_ = min((k_), cnt - 1); const unsigned e0_ = (unsigned)__builtin_amdgcn_readfirstlane((int)L[2 * kc_]), e1_ = (unsigned)__builtin_amdgcn_readfirstlane((int)L[2 * kc_ + 1]); m_ = (int)(e0_ & 0xffffu); hf_ = (int)(e0_ >> 24); off_ = (int)(e1_ & 255u); n_ = (int)(e1_ >> 8); } while (0)
#define PH_PW(k_, dst_) do { int m_, off_, n_, hf_; PH_ENT((k_), m_, off_, n_, hf_); dst_ = PLR[(size_t)m_ * 128 + min(off_ + min(gbase + 8 * hf_ + myrow_, max(n_ - 1, 0)), 127)]; } while (0)
#define PH_ROWS(S_, k_) do { int m_, off_, n_, hf_; PH_ENT((k_), m_, off_, n_, hf_); asm volatile("v_mov_b32 %0, %1" : "=v"(S_.pw) : "v"(S_.pwn));     \
        const int eo_ = (n_ > gbase + 8 * hf_ + myrow_) ? (int)(S_.pw >> 16) : 0; S_.su = SU[eo_]; S_.sv = SV[eo_]; S_.sh = ((const float*)(ws + WS_SH))[m_]; \
        _Pragma("unroll") for (int i = 0; i < 8; ++i) { const int li_ = ((i & 1) << 2) | (i & 2) | (i >> 2); const unsigned rl_ = (unsigned)__builtin_amdgcn_readlane(eo_, li_); const unsigned ro_ = rl_ * 1024u + lane16; S_.W[i] = *(const v4u*)(U8 + ro_); } \
        S_.h0 = *(const v4u*)(ws + WS_HF8 + ((unsigned)m_ * 1024u + lane16)); } while (0)
#define PH_PROC(S_, k_) do { int m_, off_, n_, hf_; PH_ENT((k_), m_, off_, n_, hf_); int f_[8]; \
        _Pragma("unroll") for (int i = 0; i < 8; ++i) { int dh; asm("v_dot4_i32_i8 %0, %1, %2, 0" : "=v"(dh) : "v"(S_.W[i].x), "v"(S_.h0.x));     dh = __builtin_amdgcn_sdot4((int)S_.W[i].y, (int)S_.h0.y, dh, false); dh = __builtin_amdgcn_sdot4((int)S_.W[i].z, (int)S_.h0.z, dh, false); f_[i] = __builtin_amdgcn_sdot4((int)S_.W[i].w, (int)S_.h0.w, dh, false); } \
        int h_[4], p_[2]; \
        _Pragma("unroll") for (int k2 = 0; k2 < 4; ++k2) { const int mine = b0_ ? f_[k2 + 4] : f_[k2], send = b0_ ? f_[k2] : f_[k2 + 4]; h_[k2] = mine + __builtin_amdgcn_update_dpp(0, send, 0xB1, 0xF, 0xF, true); } \
        _Pragma("unroll") for (int k2 = 0; k2 < 2; ++k2) { const int mine = b1_ ? h_[k2 + 2] : h_[k2], send = b1_ ? h_[k2] : h_[k2 + 2]; p_[k2] = mine + __builtin_amdgcn_update_dpp(0, send, 0x4E, 0xF, 0xF, true); } \
          \
        int t_ = __builtin_amdgcn_update_dpp(0, p_[0], 0x104, 0xF, 0x5, false); t_ = __builtin_amdgcn_update_dpp(t_, p_[1], 0x114, 0xF, 0xA, false); \
        int qi_ = (b2_ ? p_[1] : p_[0]) + t_; qi_ += __builtin_amdgcn_update_dpp(0, qi_, 0x128, 0xF, 0xF, true); \
        { const auto r_ = __builtin_amdgcn_permlane16_swap((unsigned)qi_, (unsigned)qi_, false, false); qi_ = (int)(r_[0] + r_[1]); } \
        { const auto r_ = __builtin_amdgcn_permlane32_swap((unsigned)qi_, (unsigned)qi_, false, false); qi_ = (int)(r_[0] + r_[1]); } \
        const int idx = gbase + 8 * hf_ + myrow_; \
        const float aw = __uint_as_float(S_.pw << 16) * gelu_tanh((float)qi_ * S_.su * S_.sh) * S_.sv; \
        unsigned* dst = (lane < 8 && idx < n_) ? (unsigned*)(ws + WS_PL) + ((size_t)(m_ >> 6) * 128 + off_ + idx) * 64 + (m_ & 63) : dump; const unsigned ab_ = __float_as_uint(aw); *dst = ((S_.pw >> 16) << 3) | (((ab_ + 0xffffu + ((ab_ >> 17) & 1u)) >> 17) << 17); } while (0)
    PhSet S0, S1, S2, S3;
    PH_PW(0, S0.pwn); PH_PW(1, S1.pwn); PH_PW(2, S2.pwn); PH_PW(3, S3.pwn);
    PH_ROWS(S0, 0); PH_PW(4, S0.pwn); PH_ROWS(S1, 1); PH_PW(5, S1.pwn); PH_ROWS(S2, 2); PH_PW(6, S2.pwn);
    __builtin_amdgcn_s_waitcnt(0x0F70);
#pragma nounroll
    for (int k = 0; k < cnt; k += 4) {
        PH_ROWS(S3, k + 3); PH_PW(k + 7, S3.pwn); PH_PROC(S0, k);
        PH_ROWS(S0, k + 4); PH_PW(k + 8, S0.pwn); PH_PROC(S1, k + 1);
        PH_ROWS(S1, k + 5); PH_PW(k + 9, S1.pwn); PH_PROC(S2, k + 2);
        PH_ROWS(S2, k + 6); PH_PW(k + 10, S2.pwn); PH_PROC(S3, k + 3);
    }
#undef PH_ENT
#undef PH_PW
#undef PH_ROWS
#undef PH_PROC
    __builtin_amdgcn_wave_barrier();
}
__device__ __forceinline__ void peer_u_exceptions(const Args& a, const Ctx& X) {
    const gu32* ctl = (const gu32*)(a.ws + WS_CTL); const int nexc = min((int)__hip_atomic_load(ctl + CW_NEXC, RLX_AGENT), EXC_CAP);
    for (int i = X.bid * NWAVES + X.wave; i < nexc; i += X.G * NWAVES) { const unsigned ent = __hip_atomic_load(ctl + CW_EXC + i, RLX_AGENT); const int m = (int)(ent >> 4), rr = 2 * (int)(ent & 15u);
        const unsigned char* offp = a.ws + WS_OFF + (size_t)m * 32; const int n = (int)offp[rr + 2] - (int)offp[rr];
        for (int gb = 8 * HU_MAX; gb < n; gb += 8 * HU_MAX) peer_u_pass2(a, X.lds, X.wave, m, M_TOK, 1, rr, gb, X.lane); }
}
__device__ __forceinline__ void p10u_xcd(const Args& a, const Ctx& X, int xcc, int rank) {
    const gu32* ctl = (const gu32*)(a.ws + WS_CTL); const gu32* xr = ctl + CW_XR;
    int cnt[8];
#pragma unroll
    for (int j = 0; j < 8; ++j) cnt[j] = (int)__hip_atomic_load(xr + 64 * j, RLX_AGENT);
    const bool overflow = (int)__hip_atomic_load(ctl + CW_NEXC, RLX_AGENT) > EXC_CAP;
    if (xcc < 8) { int nl = 1;
#pragma unroll
        for (int j = 0; j < 8; ++j) nl = (j == xcc) ? cnt[j] : nl;
        if (nl < 1) nl = 1;
        peer_u_pass2(a, X.lds, X.wave, rank * NWAVES + X.wave, nl * NWAVES, 1, 2 * xcc, 0, X.lane);
        if (overflow) for (int gb = 8 * HU_MAX; gb < 128; gb += 8 * HU_MAX) peer_u_pass2(a, X.lds, X.wave, rank * NWAVES + X.wave, nl * NWAVES, 1, 2 * xcc, gb, X.lane); }
#pragma nounroll
    for (int j = 0; j < 8; ++j) { int cj = 1;
#pragma unroll
        for (int q = 0; q < 8; ++q) cj = (q == j) ? cnt[q] : cj;
        if (cj == 0) { peer_u_pass2(a, X.lds, X.wave, X.bid * NWAVES + X.wave, X.G * NWAVES, 1, 2 * j, 0, X.lane);
            if (overflow) for (int gb = 8 * HU_MAX; gb < 128; gb += 8 * HU_MAX) peer_u_pass2(a, X.lds, X.wave, X.bid * NWAVES + X.wave, X.G * NWAVES, 1, 2 * j, gb, X.lane); } }
    if (!overflow) peer_u_exceptions(a, X);
}
__device__ __forceinline__ void p10_peer(const Args& a, const Ctx& X) {
    for (int i = X.tid; i < 512; i += 512) *(LAS unsigned*)(X.lds + PE_HZ + 4 * i) = 0u;
    for (int i = X.tid; i < 256 * 64; i += 512) { const int r = i >> 6, c2 = i & 63; const float2 v = ((const float2*)a.in[16])[i]; *(LAS unsigned*)(X.lds + PE_SK + r * PE_SK_ROW + 4 * c2) = pk2(v.x, v.y); }
    for (int it = X.bid; it < M_TOK / 16; it += X.G) { const int m0 = it * 16;
        __syncthreads();
        peer_route16(a, X.lds, m0, X.wave, X.lane);
        __syncthreads();
        peer_emit1(a, X.lds, m0 + 2 * X.wave, 2 * X.wave, X.lane); peer_emit1(a, X.lds, m0 + 2 * X.wave + 1, 2 * X.wave + 1, X.lane);
    }
}

__device__ __forceinline__ void p11_vslice(const Args& a, const Ctx& X) {
    unsigned char* ws = a.ws; typedef float f32x2w __attribute__((ext_vector_type(2)));
    for (int vw = X.bid; vw < 256; vw += X.G) { const int xg = vw & 7, li = vw >> 3, slice = 16 * xg + (li & 15), hf = li >> 4;
        float gi[8];
#pragma unroll
        for (int i = 0; i < 8; ++i) gi[i] = 1.f / a.in[14][8 * slice + i];
        __syncthreads();
        for (int i = X.tid; i < 16384; i += 512) *(LAS unsigned long long*)(X.lds + 8 * i) = *(const unsigned long long*)(ws + WS_V8 + (size_t)i * 1024 + 8 * slice);
        __syncthreads();
        for (int tgi = X.wave; tgi < 128; tgi += NWAVES) { const int tg = hf * 128 + tgi; const unsigned* pl = (const unsigned*)(ws + WS_PL) + (size_t)tg * 128 * 64 + X.lane;
            f32x2w acc0 = {0.f, 0.f}, acc1 = acc0, acc2 = acc0, acc3 = acc0;
            unsigned pa[8], pb[8];
#define VS_LD(P_, k_) do { _Pragma("unroll") for (int u = 0; u < 8; ++u) P_[u] = pl[(min((k_), 120) + u) * 64]; } while (0)
#define VS_USE(P_) do { _Pragma("unroll") for (int u = 0; u < 8; ++u) { const float w = __uint_as_float(P_[u] & 0xfffe0000u); const v2u q = *(const LAS v2u*)(X.lds + (P_[u] & 0x1ffffu)); const f32x2w w2 = {w, w}; \
                    acc0 += w2 * __builtin_amdgcn_cvt_pk_f32_fp8((int)q.x, false); acc1 += w2 * __builtin_amdgcn_cvt_pk_f32_fp8((int)q.x, true); \
                    acc2 += w2 * __builtin_amdgcn_cvt_pk_f32_fp8((int)q.y, false); acc3 += w2 * __builtin_amdgcn_cvt_pk_f32_fp8((int)q.y, true); } } while (0)
            VS_LD(pa, 0);
#pragma nounroll
            for (int k0 = 0; k0 < 128; k0 += 16) { VS_LD(pb, k0 + 8); VS_USE(pa); VS_LD(pa, k0 + 16); VS_USE(pb); }
#undef VS_LD
#undef VS_USE
            f32x4* orow = (f32x4*)(a.out + ((size_t)tg * 64 + X.lane) * DM + 8 * slice);
            const v4u hbv = *(const v4u*)((const bf16*)(ws + WS_HN) + ((size_t)tg * 64 + X.lane) * DM + 8 * slice);
            const f32x4 h0 = {bflo(hbv.x) * gi[0] + acc0[0], bfhi(hbv.x) * gi[1] + acc0[1], bflo(hbv.y) * gi[2] + acc1[0], bfhi(hbv.y) * gi[3] + acc1[1]};
            const f32x4 h1 = {bflo(hbv.z) * gi[4] + acc2[0], bfhi(hbv.z) * gi[5] + acc2[1], bflo(hbv.w) * gi[6] + acc3[0], bfhi(hbv.w) * gi[7] + acc3[1]};
            orow[0] = h0; orow[1] = h1; }
    }
}

constexpr int N_PHASES = 13;
__global__ void __launch_bounds__(NWAVES * 64, 2) mega_fwd(Args args) {
    extern __shared__ __attribute__((aligned(16))) unsigned char lds[];
    Ctx X; X.lds = (LAS unsigned char*)lds; X.tid = threadIdx.x; X.lane = X.tid & 63; X.wave = __builtin_amdgcn_readfirstlane(X.tid >> 6); X.G = gridDim.x; X.bid = blockIdx.x;
    volatile LAS unsigned* MISC = (volatile LAS unsigned*)(X.lds + MISC_OFF);
    unsigned char* ws = args.ws;
    for (int u = X.tid; u < (LDS_BYTES - LDSCTL_OFF) / 4; u += NWAVES * 64) ((LAS unsigned*)(X.lds + LDSCTL_OFF))[u] = 0u;
    __syncthreads();
    XcdBarrier bar = xcd_barrier_post((unsigned*)(ws + WS_CTL) + CW_BAR, MISC + 8);
    if (X.tid == 0) { const unsigned xc = xb_xcc_id(); MISC[12] = xc; MISC[13] = __hip_atomic_fetch_add((gu32*)(ws + WS_CTL) + CW_XR + 64 * (xc & 7u), 1u, RLX_AGENT); }
    const int lo = args.ph_lo, hi = args.ph_hi;
#define IN(k) (lo <= (k) && (k) < hi)
#define SEAM(k) do { if (IN(k) && IN((k) + 1)) xcd_barrier(bar); FRESH(); } while (0)
#define FRESH() do { int t_ = threadIdx.x; asm volatile("" : "+v"(t_)); X.tid = t_; X.lane = t_ & 63; X.wave = __builtin_amdgcn_readfirstlane(t_ >> 6); } while (0)

    if (IN(0)) { p0_prologue(args, X); }
    SEAM(0);
    if (IN(1)) { auto run_ = [&]() __attribute__((always_inline)) {
        pg8::Gemm g{(const pg8::bf16_t*)args.out, (const pg8::bf16_t*)(ws + WS_WIN), M_TOK, N_PROJ, 1024, 1024, 1024}; pg8::StaticOrder S; S.init(M_TOK, N_PROJ, X.G, X.bid);
        ProjHeadEpi E{(bf16*)(ws + WS_PROJ), (bf16*)(ws + WS_KCVC), (bf16*)(ws + WS_KCVC) + (size_t)4 * SEQ * 64, args.in[3], args.in[4], (const float2*)(ws + WS_ROPE)};
        pg8::gemm_phase<ProjHeadEpi, pg8::StaticOrder, true, true>(X.lds + RING_OFF, g, S, E);
        pg8::Gemm g8{(const pg8::bf16_t*)((const unsigned char*)args.out + XN8_OFF), (const pg8::bf16_t*)(ws + WS_WIN8), M_TOK, N1 - N_PROJ, 512, 512, 512}; pg8::StaticOrder S8; S8.init(M_TOK, N1 - N_PROJ, X.G, X.G - 1 - X.bid);
        pg8::EpiP8<ProjEpiG8> E8{{{(bf16*)(ws + WS_PROJ), ws + WS_GATE, (float*)(ws + WS_GN)}}};
        pg8::gemm_phase<pg8::EpiP8<ProjEpiG8>, pg8::StaticOrder, true, true, true>(X.lds + RING_OFF, g8, S8, E8);
        }; run_(); }
    SEAM(1);
    if (IN(3)) { auto run_ = [&]() __attribute__((always_inline)) {
        if (X.bid < 16) {
        pg8::Gemm g{(const pg8::bf16_t*)(ws + WS_KCVC), (const pg8::bf16_t*)(ws + WS_W1), 4096, 512, 2048, 1024, 2048}; pg8::ListOrder S{16, 8, X.G, X.bid};
        CmpFusedEpi E{(const float*)(ws + WS_BIAS), (const bf16*)(ws + WS_W2T), args.in[4], (const float2*)(ws + WS_ROPE), (bf16*)(ws + WS_KC16), (bf16*)(ws + WS_VC16)};
        pg8::gemm_phase<CmpFusedEpi, pg8::ListOrder, false, true>(X.lds + RING_OFF, g, S, E);
        } else p3_sb(args, X, X.bid - 16, X.G - 16);
        }; run_(); }
    SEAM(3);
    if (IN(5)) { p5_mixers(args, X); }
    SEAM(5);
    if (IN(6)) { auto run_ = [&]() __attribute__((always_inline)) {
        pg8::Gemm g{(const pg8::bf16_t*)(ws + WS_ONSA), (const pg8::bf16_t*)(ws + WS_WA), 2 * M_TOK, 2048, 256, 256, 256}; MergeOrder S; S.S0.init(M_TOK, 1024, X.G, X.bid);
        pg8::EpiN4<MergeEpiF> E{{ws + WS_GATE, (bf16*)(ws + WS_MERGED), ws + WS_M8}};
        pg8::gemm_phase<pg8::EpiN4<MergeEpiF>, MergeOrder, true, true, true>(X.lds + RING_OFF, g, S, E);
        }; run_(); }
    SEAM(6);
    if (IN(7)) { auto run_ = [&]() __attribute__((always_inline)) {
        pg8::Gemm g{(const pg8::bf16_t*)(ws + WS_M8), (const pg8::bf16_t*)(ws + WS_WO), M_TOK, 1024, 512, 512, 512}; pg8::StaticOrder S; S.init(M_TOK, 1024, X.G, X.bid);
        OutNormEpi E{args.in[0], args.out, (bf16*)(ws + WS_HN), args.in[14], (float*)(ws + WS_ROWSS)};
        pg8::gemm_phase<OutNormEpi, pg8::StaticOrder, true, true, true>(X.lds + RING_OFF, g, S, E);
        }; run_(); }
    SEAM(7);
    if (IN(9)) { auto run_ = [&]() __attribute__((always_inline)) {
        pg8::Gemm g{(const pg8::bf16_t*)(ws + WS_HN), (const pg8::bf16_t*)(ws + WS_WQ), M_TOK, 2048, 1024, 1024, 1024}; pg8::StaticOrder S; S.init(M_TOK, 2048, X.G, X.bid);
        QpNormEpi E{(bf16*)(ws + WS_QP), (const float*)(ws + WS_ROWSS)};
        pg8::gemm_phase<QpNormEpi, pg8::StaticOrder, true, true>(X.lds + RING_OFF, g, S, E);
        }; run_(); }
    SEAM(9);
    if (IN(10)) p10_peer(args, X);
    SEAM(10);
    if (IN(11)) { p10u_xcd(args, X, (int)MISC[12], (int)MISC[13]); }
    SEAM(11);
    if (IN(12)) p11_vslice(args, X);
#undef IN
#undef SEAM
}

extern "C" void kernel_launch(void* const* d_in, const int* in_sizes, int n_in, void* d_out, int out_size, void* d_ws, size_t ws_size, hipStream_t stream) {
    static int grid = 0;
    if (grid == 0) {
        int dev = 0, cus = 0, per_cu = 0;
        if (hipGetDevice(&dev) != hipSuccess || hipDeviceGetAttribute(&cus, hipDeviceAttributeMultiprocessorCount, dev) != hipSuccess) { fprintf(stderr, "kernel_launch: device query failed\n"); grid = -1; return; }
        if (hipFuncSetAttribute((const void*)mega_fwd, hipFuncAttributeMaxDynamicSharedMemorySize, LDS_BYTES) != hipSuccess) { fprintf(stderr, "kernel_launch: hipFuncSetAttribute failed\n"); grid = -1; return; }
        if (hipOccupancyMaxActiveBlocksPerMultiprocessor(&per_cu, (const void*)mega_fwd, NWAVES * 64, LDS_BYTES) != hipSuccess || per_cu < 1) { fprintf(stderr, "kernel_launch: occupancy query says %d\n", per_cu); }
        (void)hipGetLastError();
        grid = cus;
        if (ws_size < 256 * MiB) fprintf(stderr, "kernel_launch: workspace too small: %zu\n", ws_size);
    }
    if (grid < 0) return;
    (void)hipMemsetAsync((char*)d_ws + WS_CTL, 0, CTL_ZERO_BYTES, stream);
    Args a{};
    for (int i = 0; i < 19; ++i) a.in[i] = (const float*)d_in[i];
    a.out = (float*)d_out; a.ws = (unsigned char*)d_ws;
    a.ph_lo = 0; a.ph_hi = N_PHASES;
    hipLaunchKernelGGL(mega_fwd, dim3(grid), dim3(NWAVES * 64), LDS_BYTES, stream, a);
}
```
